# Optimizing an MI355X kernel written in HIP

```python
import jax, jax.numpy as jnp
from jax import lax
import numpy as np

D_MODEL = 1024
BATCH = 2
SEQ = 8192
DEPTH = 1

HEAD_DIM = 64
NSA_HEADS = 8
NSA_KV_HEADS = 2
NSA_GROUP = NSA_HEADS // NSA_KV_HEADS
CMP_STRIDE = 16
CMP_LEN = 2 * CMP_STRIDE
CMP_HIDDEN = 256
SEL_BLOCK = 64
N_SEL = 16
WINDOW = 512
MOBA_HEADS = 8
MOBA_BLOCK = 256
MOBA_TOPK = 3
N_EXPERTS = 256
TOP_K = 8
N_GROUPS = 8
TOPK_GROUPS = 4
D_EXPERT = 256
D_SHARED = 256
ROUTE_SCALE = 2.5
MOE_ROW_BLOCK = 128

Q_CHUNK = 64
RMS_EPS = 1e-6

NSA_Q = NSA_HEADS * HEAD_DIM
NSA_KV = NSA_KV_HEADS * HEAD_DIM
NSA_GATES = NSA_HEADS * 3
MOBA_W = MOBA_HEADS * HEAD_DIM
IN_SIZES = [NSA_Q, 6 * NSA_KV, NSA_GATES, 3 * MOBA_W, D_MODEL, D_MODEL]
IN_COLS = sum(IN_SIZES)

kernel_name = "hybrid_nsa_moba_moe_adaln_block"


def alibi_slopes():
    n = NSA_HEADS + MOBA_HEADS
    s = 2.0 ** (-8.0 * np.arange(1, n + 1) / n)
    return jnp.asarray(s[0::2], jnp.float32), jnp.asarray(s[1::2], jnp.float32)


def rmsnorm(x, g):
    xf = x.astype(jnp.float32)
    y = xf * lax.rsqrt(jnp.mean(xf * xf, axis=-1, keepdims=True) + RMS_EPS)
    return (y * g.astype(jnp.float32)).astype(x.dtype)


def masked_softmax(s, mask):
    s = jnp.where(mask, s, -jnp.inf)
    m = jnp.max(s, axis=-1, keepdims=True)
    m = jnp.where(jnp.isfinite(m), m, 0.0)
    e = jnp.exp(s - m)
    return e / jnp.maximum(jnp.sum(e, axis=-1, keepdims=True), 1e-30)


def compress_kv(k, pe, w1, b1, w2):
    b_, h_, s_, dh = k.shape
    k16 = k.reshape(b_, h_, s_ // CMP_STRIDE, CMP_STRIDE, dh)
    blocks = jnp.concatenate([k16[:, :, :-1], k16[:, :, 1:]], axis=3) + pe
    flat = blocks.reshape(b_, h_, -1, CMP_LEN * dh)
    return jax.nn.gelu(flat @ w1 + b1) @ w2


_gather_blocks = jax.vmap(jax.vmap(lambda blk, ix: blk[ix]))


def nsa_attention(q, k_c, v_c, k_s, v_s, k_w, v_w, gates,
                  pe_k, w1_k, b1_k, w2_k, pe_v, w1_v, b1_v, w2_v, slopes):
    b_, hkv, g_, s_, dh = q.shape
    scale = dh ** -0.5
    kc = compress_kv(k_c, pe_k, w1_k, b1_k, w2_k)
    vc = compress_kv(v_c, pe_v, w1_v, b1_v, w2_v)
    nc = kc.shape[2]
    c_end = jnp.arange(nc) * CMP_STRIDE + CMP_LEN - 1
    c_mid = jnp.arange(nc, dtype=jnp.float32) * CMP_STRIDE + (CMP_LEN - 1) / 2
    ns = s_ // SEL_BLOCK
    n_sel = min(N_SEL, ns)
    ratio = SEL_BLOCK // CMP_STRIDE
    span = CMP_LEN // CMP_STRIDE
    jj = np.arange(ns)
    imp_idx = jnp.asarray((ratio * jj[:, None, None] + np.arange(ratio)[None, :, None]
                           - np.arange(span)[None, None, :] + 1).reshape(ns, -1))
    k_sb = k_s.reshape(b_, hkv, ns, SEL_BLOCK, dh)
    v_sb = v_s.reshape(b_, hkv, ns, SEL_BLOCK, dh)
    padw = ((0, 0), (0, 0), (WINDOW, 0), (0, 0))
    k_wp = jnp.pad(k_w, padw)
    v_wp = jnp.pad(v_w, padw)
    sl = slopes.reshape(hkv, g_)[None, :, :, None, None]
    jb = jnp.arange(ns)

    def chunk(s0):
        t = s0 + jnp.arange(Q_CHUNK)
        tf = t.astype(jnp.float32)
        qc = lax.dynamic_slice_in_dim(q, s0, Q_CHUNK, axis=3) * scale
        sc = jnp.einsum('bhgqd,bhcd->bhgqc', qc, kc).astype(jnp.float32) \
            - sl * (tf[:, None] - c_mid[None, :])
        p_c = masked_softmax(sc, c_end[None, :] <= t[:, None])
        o_c = jnp.einsum('bhgqc,bhcd->bhgqd', p_c.astype(vc.dtype), vc)
        p_grp = jnp.pad(p_c.sum(axis=2), ((0, 0), (0, 0), (0, 0), (1, 1)))
        imp = jnp.take(p_grp, imp_idx, axis=-1).sum(-1)
        cur = t // SEL_BLOCK
        forced = (jb[None, :] == 0) | (jb[None, :] == cur[:, None]) | (jb[None, :] == cur[:, None] - 1)
        imp = jnp.where(forced, jnp.inf, imp)
        imp = jnp.where(jb[None, :] > cur[:, None], -jnp.inf, imp)
        _, sel = lax.top_k(imp, n_sel)
        ks = _gather_blocks(k_sb, sel).reshape(b_, hkv, Q_CHUNK, n_sel * SEL_BLOCK, dh)
        vs = _gather_blocks(v_sb, sel).reshape(b_, hkv, Q_CHUNK, n_sel * SEL_BLOCK, dh)
        pos = (sel[..., None] * SEL_BLOCK + jnp.arange(SEL_BLOCK)).reshape(b_, hkv, Q_CHUNK, -1)
        dist = (t[:, None] - pos)[:, :, None]
        ss = jnp.einsum('bhgqd,bhqkd->bhgqk', qc, ks).astype(jnp.float32) - sl * dist.astype(jnp.float32)
        p_s = masked_softmax(ss, dist >= 0)
        o_s = jnp.einsum('bhgqk,bhqkd->bhgqd', p_s.astype(vs.dtype), vs)
        kw = lax.dynamic_slice_in_dim(k_wp, s0, Q_CHUNK + WINDOW, axis=2)
        vw = lax.dynamic_slice_in_dim(v_wp, s0, Q_CHUNK + WINDOW, axis=2)
        posw = s0 - WINDOW + jnp.arange(Q_CHUNK + WINDOW)
        dw = t[:, None] - posw[None, :]
        sw = jnp.einsum('bhgqd,bhkd->bhgqk', qc, kw).astype(jnp.float32) - sl * dw.astype(jnp.float32)
        p_w = masked_softmax(sw, (dw >= 0) & (dw < WINDOW) & (posw[None, :] >= 0))
        o_w = jnp.einsum('bhgqk,bhkd->bhgqd', p_w.astype(vw.dtype), vw)
        g = lax.dynamic_slice_in_dim(gates, s0, Q_CHUNK, axis=3)
        return g[..., 0:1] * o_c + g[..., 1:2] * o_s + g[..., 2:3] * o_w

    out = lax.map(chunk, jnp.arange(s_ // Q_CHUNK) * Q_CHUNK)
    return out.transpose(1, 0, 4, 2, 3, 5).reshape(b_, s_, hkv * g_ * dh)


def moba_attention(q, k, v, slopes):
    b_, h_, s_, dh = q.shape
    scale = dh ** -0.5
    nb = -(-s_ // MOBA_BLOCK)
    pad = ((0, 0), (0, 0), (0, nb * MOBA_BLOCK - s_), (0, 0))
    kp = jnp.pad(k, pad)
    vp = jnp.pad(v, pad)
    kb = kp.reshape(b_, h_, nb, MOBA_BLOCK, dh)
    vb = vp.reshape(b_, h_, nb, MOBA_BLOCK, dh)
    kmean = jnp.mean(kb.astype(jnp.float32), axis=3).astype(k.dtype)
    n_top = min(MOBA_TOPK, nb - 1)
    sl = slopes[None, :, None, None]

    def chunk(s0):
        t = s0 + jnp.arange(Q_CHUNK)
        qc = lax.dynamic_slice_in_dim(q, s0, Q_CHUNK, axis=2) * scale
        cur = t // MOBA_BLOCK
        start = (s0 // MOBA_BLOCK) * MOBA_BLOCK
        ko = lax.dynamic_slice_in_dim(kp, start, MOBA_BLOCK, axis=2)
        vo = lax.dynamic_slice_in_dim(vp, start, MOBA_BLOCK, axis=2)
        d_o = t[:, None] - (start + jnp.arange(MOBA_BLOCK))[None, :]
        s_o = jnp.einsum('bhqd,bhkd->bhqk', qc, ko).astype(jnp.float32) - sl * d_o.astype(jnp.float32)
        m_o = jnp.broadcast_to(d_o >= 0, s_o.shape)
        if n_top > 0:
            gate = jnp.einsum('bhqd,bhnd->bhqn', qc, kmean).astype(jnp.float32)
            past = jnp.arange(nb)[None, :] < cur[:, None]
            _, sel = lax.top_k(jnp.where(past, gate, -jnp.inf), n_top)
            ok = jnp.repeat(sel < cur[:, None], MOBA_BLOCK, axis=-1)
            ks = _gather_blocks(kb, sel).reshape(b_, h_, Q_CHUNK, n_top * MOBA_BLOCK, dh)
            vs = _gather_blocks(vb, sel).reshape(b_, h_, Q_CHUNK, n_top * MOBA_BLOCK, dh)
            pos_s = (sel[..., None] * MOBA_BLOCK + jnp.arange(MOBA_BLOCK)).reshape(b_, h_, Q_CHUNK, -1)
            s_s = jnp.einsum('bhqd,bhqkd->bhqk', qc, ks).astype(jnp.float32) \
                - sl * (t[:, None] - pos_s).astype(jnp.float32)
            p = masked_softmax(jnp.concatenate([s_s, s_o], axis=-1),
                               jnp.concatenate([ok, m_o], axis=-1)).astype(v.dtype)
            n_s = n_top * MOBA_BLOCK
            return jnp.einsum('bhqk,bhqkd->bhqd', p[..., :n_s], vs) + \
                jnp.einsum('bhqk,bhkd->bhqd', p[..., n_s:], vo)
        p = masked_softmax(s_o, m_o).astype(v.dtype)
        return jnp.einsum('bhqk,bhkd->bhqd', p, vo)

    out = lax.map(chunk, jnp.arange(s_ // Q_CHUNK) * Q_CHUNK)
    return out.transpose(1, 0, 3, 2, 4).reshape(b_, s_, h_ * dh)


def hybrid_mixer(h, w_in, pe_k, w1_k, b1_k, w2_k, pe_v, w1_v, b1_v, w2_v,
                 w_up_a, w_up_b, w_out, slopes_a, slopes_b):
    b_, s_, _ = h.shape
    proj = h @ w_in
    q_a, kv_a, g_a, qkv_b, gate_a, gate_b = jnp.split(proj, [int(i) for i in np.cumsum(IN_SIZES)[:-1]], axis=-1)
    q_a = q_a.reshape(b_, s_, NSA_KV_HEADS, NSA_GROUP, HEAD_DIM).transpose(0, 2, 3, 1, 4)
    kv_a = kv_a.reshape(b_, s_, 6, NSA_KV_HEADS, HEAD_DIM).transpose(2, 0, 3, 1, 4)
    g_a = jax.nn.sigmoid(g_a).reshape(b_, s_, NSA_KV_HEADS, NSA_GROUP, 3).transpose(0, 2, 3, 1, 4)
    o_a = nsa_attention(q_a, kv_a[0], kv_a[1], kv_a[2], kv_a[3], kv_a[4], kv_a[5], g_a,
                        pe_k, w1_k, b1_k, w2_k, pe_v, w1_v, b1_v, w2_v, slopes_a)
    qkv_b = qkv_b.reshape(b_, s_, 3, MOBA_HEADS, HEAD_DIM).transpose(2, 0, 3, 1, 4)
    o_b = moba_attention(qkv_b[0], qkv_b[1], qkv_b[2], slopes_b)
    merged = jax.nn.sigmoid(gate_a) * (o_a @ w_up_a) + jax.nn.sigmoid(gate_b) * (o_b @ w_up_b)
    return merged @ w_out


def route(h2d, w_router, router_bias):
    t_ = h2d.shape[0]
    s = jax.nn.sigmoid((h2d @ w_router).astype(jnp.float32))
    sb = s + router_bias.astype(jnp.float32)
    gscore = lax.top_k(sb.reshape(t_, N_GROUPS, -1), 2)[0].sum(-1)
    _, gidx = lax.top_k(gscore, TOPK_GROUPS)
    gmask = jnp.any(gidx[..., None] == jnp.arange(N_GROUPS), axis=1)
    emask = jnp.repeat(gmask, N_EXPERTS // N_GROUPS, axis=1)
    _, eidx = lax.top_k(jnp.where(emask, sb, -jnp.inf), TOP_K)
    w = jnp.take_along_axis(s, eidx, axis=1)
    w = w / jnp.sum(w, axis=-1, keepdims=True) * ROUTE_SCALE
    return eidx, w


def routed_experts(h2d, eidx, wts, w_gate, w_up, w_down):
    t_, d_ = h2d.shape
    a_ = t_ * TOP_K
    blk = MOE_ROW_BLOCK
    nb = -(-(a_ + N_EXPERTS * (blk - 1)) // blk)
    flat_e = eidx.reshape(-1)
    flat_tok = jnp.repeat(jnp.arange(t_, dtype=jnp.int32), TOP_K)
    flat_w = wts.reshape(-1)
    order = jnp.argsort(flat_e)
    e_sorted = flat_e[order]
    counts = jnp.bincount(flat_e, length=N_EXPERTS)
    start = jnp.cumsum(counts) - counts
    padded = (counts + blk - 1) // blk * blk
    pad_end = jnp.cumsum(padded)
    pad_start = pad_end - padded
    dest = pad_start[e_sorted] + jnp.arange(a_) - start[e_sorted]
    row_tok = jnp.full((nb * blk,), t_, jnp.int32).at[dest].set(flat_tok[order])
    row_w = jnp.zeros((nb * blk,), h2d.dtype).at[dest].set(flat_w[order].astype(h2d.dtype))
    blk_e = jnp.minimum(jnp.searchsorted(pad_end, jnp.arange(nb) * blk, side='right'), N_EXPERTS - 1)
    x_pad = jnp.concatenate([h2d, jnp.zeros((1, d_), h2d.dtype)], axis=0)

    def step(acc, inp):
        tok, w, e = inp
        xb = x_pad[tok]
        hb = jax.nn.silu(xb @ w_gate[e]) * (xb @ w_up[e])
        return acc.at[tok].add((hb @ w_down[e]) * w[:, None]), None

    acc, _ = lax.scan(step, jnp.zeros((t_ + 1, d_), h2d.dtype),
                      (row_tok.reshape(nb, blk), row_w.reshape(nb, blk), blk_e))
    return acc[:t_]


def moe_ffn(h, w_router, router_bias, w_e_gate, w_e_up, w_e_down, w_s_gate, w_s_up, w_s_down):
    b_, s_, d_ = h.shape
    h2 = h.reshape(-1, d_)
    eidx, wts = route(h2, w_router, router_bias)
    y = routed_experts(h2, eidx, wts, w_e_gate, w_e_up, w_e_down)
    y = y + (jax.nn.silu(h2 @ w_s_gate) * (h2 @ w_s_up)) @ w_s_down
    return y.reshape(b_, s_, d_)


def setup_inputs(seed: int = 0) -> dict:
    key = jax.random.key(seed)
    ks = jax.random.split(key, 32)
    L, D = DEPTH, D_MODEL

    def nrm(k, shape, scale):
        return jax.random.normal(k, shape, jnp.float32) * scale

    return {
        "x": nrm(ks[0], (BATCH, SEQ, D), 1.0),
        "c": nrm(ks[1], (BATCH, D), 1.0),
        "w_ada": nrm(ks[2], (L, D, 6 * D), 0.5 * D ** -0.5),
        "b_ada": nrm(ks[3], (L, 6 * D), 0.01),
        "norm1_g": 1.0 + nrm(ks[4], (L, D), 0.02),
        "w_in": nrm(ks[5], (L, D, IN_COLS), D ** -0.5),
        "cmp_pe_k": nrm(ks[6], (L, CMP_LEN, HEAD_DIM), 0.1),
        "cmp_w1_k": nrm(ks[7], (L, CMP_LEN * HEAD_DIM, CMP_HIDDEN), (CMP_LEN * HEAD_DIM) ** -0.5),
        "cmp_b1_k": nrm(ks[8], (L, CMP_HIDDEN), 0.01),
        "cmp_w2_k": nrm(ks[9], (L, CMP_HIDDEN, HEAD_DIM), CMP_HIDDEN ** -0.5),
        "cmp_pe_v": nrm(ks[10], (L, CMP_LEN, HEAD_DIM), 0.1),
        "cmp_w1_v": nrm(ks[11], (L, CMP_LEN * HEAD_DIM, CMP_HIDDEN), (CMP_LEN * HEAD_DIM) ** -0.5),
        "cmp_b1_v": nrm(ks[12], (L, CMP_HIDDEN), 0.01),
        "cmp_w2_v": nrm(ks[13], (L, CMP_HIDDEN, HEAD_DIM), CMP_HIDDEN ** -0.5),
        "w_up_a": nrm(ks[14], (L, NSA_Q, D), NSA_Q ** -0.5),
        "w_up_b": nrm(ks[15], (L, MOBA_W, D), MOBA_W ** -0.5),
        "w_out": nrm(ks[16], (L, D, D), D ** -0.5),
        "norm2_g": 1.0 + nrm(ks[17], (L, D), 0.02),
        "w_router": nrm(ks[18], (L, D, N_EXPERTS), D ** -0.5),
        "router_bias": nrm(ks[19], (L, N_EXPERTS), 0.01),
        "w_e_gate": nrm(ks[20], (L, N_EXPERTS, D, D_EXPERT), D ** -0.5),
        "w_e_up": nrm(ks[21], (L, N_EXPERTS, D, D_EXPERT), D ** -0.5),
        "w_e_down": nrm(ks[22], (L, N_EXPERTS, D_EXPERT, D), D_EXPERT ** -0.5),
        "w_s_gate": nrm(ks[23], (L, D, D_SHARED), D ** -0.5),
        "w_s_up": nrm(ks[24], (L, D, D_SHARED), D ** -0.5),
        "w_s_down": nrm(ks[25], (L, D_SHARED, D), D_SHARED ** -0.5),
        "final_g": 1.0 + nrm(ks[26], (D,), 0.02),
    }


def reference(x, c, w_ada, b_ada, norm1_g, w_in, cmp_pe_k, cmp_w1_k, cmp_b1_k, cmp_w2_k,
              cmp_pe_v, cmp_w1_v, cmp_b1_v, cmp_w2_v, w_up_a, w_up_b, w_out, norm2_g,
              w_router, router_bias, w_e_gate, w_e_up, w_e_down, w_s_gate, w_s_up, w_s_down,
              final_g):
    slopes_a, slopes_b = alibi_slopes()
    for l in range(DEPTH):
        ada = jax.nn.silu(c) @ w_ada[l] + b_ada[l]
        sh1, sc1, g1, sh2, sc2, g2 = [a[:, None, :] for a in jnp.split(ada, 6, axis=-1)]
        h = rmsnorm(x, norm1_g[l]) * (1 + sc1) + sh1
        mix = hybrid_mixer(h, w_in[l], cmp_pe_k[l], cmp_w1_k[l], cmp_b1_k[l], cmp_w2_k[l],
                           cmp_pe_v[l], cmp_w1_v[l], cmp_b1_v[l], cmp_w2_v[l],
                           w_up_a[l], w_up_b[l], w_out[l], slopes_a, slopes_b)
        x = x + g1 * mix
        h = rmsnorm(x, norm2_g[l]) * (1 + sc2) + sh2
        x = x + g2 * moe_ffn(h, w_router[l], router_bias[l], w_e_gate[l], w_e_up[l], w_e_down[l],
                             w_s_gate[l], w_s_up[l], w_s_down[l])
    return rmsnorm(x, final_g)
```

```cpp
#include <hip/hip_runtime.h>
#include <hip/hip_cooperative_groups.h>
#include <cstdio>
#include <cstdint>
namespace cg = cooperative_groups;

typedef float f32x16 __attribute__((ext_vector_type(16)));
typedef short bf16x8 __attribute__((ext_vector_type(8)));
typedef short v4i16_t __attribute__((ext_vector_type(4)));
typedef __bf16 bf16x2_t __attribute__((ext_vector_type(2)));
typedef float f32x2_t __attribute__((ext_vector_type(2)));
typedef unsigned short bf16;
#define LAS __attribute__((address_space(3)))
__device__ __forceinline__ unsigned pk2(float a, float b) { f32x2_t v = {a, b}; bf16x2_t r = __builtin_convertvector(v, bf16x2_t); return __builtin_bit_cast(unsigned, r); }
__device__ __forceinline__ bf16 f2bf(float a) { return (bf16)(pk2(a, 0.f) & 0xffffu); }
__device__ __forceinline__ float bf2f(bf16 u) { return __uint_as_float((unsigned)u << 16); }
__device__ __forceinline__ uint4 pack8(float4 a, float4 b) { uint4 r; r.x = pk2(a.x, a.y); r.y = pk2(a.z, a.w); r.z = pk2(b.x, b.y); r.w = pk2(b.z, b.w); return r; }

#ifndef PHASES
#define PHASES 0xffffu
#endif
#ifndef REPMASK
#define REPMASK 0u
#endif
constexpr int NT = 256;
constexpr int T = 16384, S = 8192, D = 1024, INC = 4888;
constexpr int NC = 511;
constexpr int NSLOT = 131072 + 256 * 128;

struct Params {
  const float *x, *c, *w_ada, *b_ada, *norm1_g, *w_in, *pe_k, *w1_k, *b1_k, *w2_k, *pe_v, *w1_v, *b1_v, *w2_v;
  const float *w_up_a, *w_up_b, *w_out, *norm2_g, *w_router, *router_bias, *w_e_gate, *w_e_up, *w_e_down;
  const float *w_s_gate, *w_s_up, *w_s_down, *final_g;
  float* out; unsigned char* ws;
};

constexpr size_t al(size_t x) { return (x + 255) & ~(size_t)255; }
constexpr int XCD_BAR_WORDS_C = 3456;
constexpr size_t O_ADAP = 0;
constexpr size_t O_ADA = O_ADAP + al(32 * 2 * 6144 * 4);
constexpr size_t O_CNT = O_ADA + al(2 * 6144 * 4);
constexpr size_t O_NRB = O_CNT + al(256 * 4);
constexpr size_t O_BLKE = O_NRB + al(256);
constexpr size_t O_ERB = O_BLKE + al(2048 * 4);
constexpr size_t O_BAR = O_ERB + al(1024 * 4);
constexpr size_t O_TMPF = O_BAR + al(XCD_BAR_WORDS_C * 4);
constexpr size_t O_H1B = O_TMPF + al((size_t)T * D * 4);
constexpr size_t O_MRG = O_H1B + al((size_t)T * D * 2);
constexpr size_t O_QA = O_MRG + al((size_t)T * D * 2);
constexpr size_t O_KVA = O_QA + al((size_t)T * 512 * 2);
constexpr size_t O_GA = O_KVA + al((size_t)6 * T * 128 * 2);
constexpr size_t O_QKVB = O_GA + al((size_t)T * 24 * 4);
constexpr size_t O_GAB = O_QKVB + al((size_t)3 * T * 512 * 2);
constexpr size_t O_HIDC = O_GAB + al((size_t)T * 2048 * 2);
constexpr size_t O_KC = O_HIDC + al((size_t)2 * 2044 * 256 * 2);
constexpr size_t O_KMEAN = O_KC + al((size_t)2 * 4 * 512 * 64 * 2);
constexpr size_t O_OA = O_KMEAN + al((size_t)16 * 64 * 64 * 2);
constexpr size_t O_OB = O_OA + al((size_t)T * 512 * 2);
constexpr size_t O_X1 = O_OB + al((size_t)T * 512 * 2);
constexpr size_t O_LOG = O_X1 + al((size_t)T * D * 4);
constexpr size_t O_Y = O_LOG + al((size_t)T * 256 * 4);
constexpr size_t O_SHID = O_Y + al((size_t)T * D * 4);
constexpr size_t O_EIDX = O_SHID + al((size_t)T * 256 * 2);
constexpr size_t O_WTS = O_EIDX + al((size_t)T * 8 * 4);
constexpr size_t O_POS = O_WTS + al((size_t)T * 8 * 4);
constexpr size_t O_RTOK = O_POS + al((size_t)T * 8 * 4);
constexpr size_t O_RW = O_RTOK + al((size_t)NSLOT * 4);
constexpr size_t O_HID = O_RW + al((size_t)NSLOT * 4);
constexpr size_t O_YE = O_HID + al((size_t)NSLOT * 256 * 2);
constexpr size_t O_WIN = O_YE + al((size_t)T * 8 * D * 2);
constexpr size_t O_WUPA = O_WIN + al((size_t)D * INC * 2);
constexpr size_t O_WUPB = O_WUPA + al((size_t)512 * D * 2);
constexpr size_t O_WOUT = O_WUPB + al((size_t)512 * D * 2);
constexpr size_t O_WRT = O_WOUT + al((size_t)D * D * 2);
constexpr size_t O_WSG = O_WRT + al((size_t)D * 256 * 2);
constexpr size_t O_WSU = O_WSG + al((size_t)D * 256 * 2);
constexpr size_t O_WSD = O_WSU + al((size_t)D * 256 * 2);
constexpr size_t O_MBCNT = O_WSD + al((size_t)256 * D * 2);
constexpr size_t O_MBQL = O_MBCNT + al(1024 * 4);
constexpr size_t O_MBLSE = O_MBQL + al((size_t)512 * 8192 * 2);
constexpr size_t O_END = O_MBLSE + al((size_t)T * 8 * 4 * 4);
constexpr size_t O_MBPART = O_YE;
static_assert(O_END <= ((size_t)1 << 30), "workspace map exceeds 1 GiB");

struct WS {
  unsigned char* base;
  __device__ __forceinline__ float* adap() const { return (float*)(base + O_ADAP); }
  __device__ __forceinline__ float* ada() const { return (float*)(base + O_ADA); }
  __device__ __forceinline__ float* tmpf() const { return (float*)(base + O_TMPF); }
  __device__ __forceinline__ float* ga() const { return (float*)(base + O_GA); }
  __device__ __forceinline__ bf16* gab() const { return (bf16*)(base + O_GAB); }
  __device__ __forceinline__ float* x1() const { return (float*)(base + O_X1); }
  __device__ __forceinline__ float* logits() const { return (float*)(base + O_LOG); }
  __device__ __forceinline__ float* y() const { return (float*)(base + O_Y); }
  __device__ __forceinline__ float* wts() const { return (float*)(base + O_WTS); }
  __device__ __forceinline__ float* row_w() const { return (float*)(base + O_RW); }
  __device__ __forceinline__ bf16* h1b() const { return (bf16*)(base + O_H1B); }
  __device__ __forceinline__ bf16* mrg() const { return (bf16*)(base + O_MRG); }
  __device__ __forceinline__ bf16* hidc() const { return (bf16*)(base + O_HIDC); }
  __device__ __forceinline__ bf16* oa() const { return (bf16*)(base + O_OA); }
  __device__ __forceinline__ bf16* ob() const { return (bf16*)(base + O_OB); }
  __device__ __forceinline__ bf16* shid() const { return (bf16*)(base + O_SHID); }
  __device__ __forceinline__ bf16* hid() const { return (bf16*)(base + O_HID); }
  __device__ __forceinline__ bf16* ye() const { return (bf16*)(base + O_YE); }
  __device__ __forceinline__ bf16* mbpart() const { return (bf16*)(base + O_MBPART); }
  __device__ __forceinline__ int* mbcnt() const { return (int*)(base + O_MBCNT); }
  __device__ __forceinline__ unsigned short* mbql() const { return (unsigned short*)(base + O_MBQL); }
  __device__ __forceinline__ float* mblse() const { return (float*)(base + O_MBLSE); }
  __device__ __forceinline__ bf16* wb_in() const { return (bf16*)(base + O_WIN); }
  __device__ __forceinline__ bf16* wb_upa() const { return (bf16*)(base + O_WUPA); }
  __device__ __forceinline__ bf16* wb_upb() const { return (bf16*)(base + O_WUPB); }
  __device__ __forceinline__ bf16* wb_out() const { return (bf16*)(base + O_WOUT); }
  __device__ __forceinline__ bf16* wb_rt() const { return (bf16*)(base + O_WRT); }
  __device__ __forceinline__ bf16* wb_sg() const { return (bf16*)(base + O_WSG); }
  __device__ __forceinline__ bf16* wb_su() const { return (bf16*)(base + O_WSU); }
  __device__ __forceinline__ bf16* wb_sd() const { return (bf16*)(base + O_WSD); }
  __device__ __forceinline__ bf16* qa() const { return (bf16*)(base + O_QA); }
  __device__ __forceinline__ bf16* kva() const { return (bf16*)(base + O_KVA); }
  __device__ __forceinline__ bf16* qkvb() const { return (bf16*)(base + O_QKVB); }
  __device__ __forceinline__ int* etok() const { return (int*)(base + O_QKVB); }
  __device__ __forceinline__ bf16* kcb() const { return (bf16*)(base + O_KC); }
  __device__ __forceinline__ bf16* kmb() const { return (bf16*)(base + O_KMEAN); }
  __device__ __forceinline__ int* counts() const { return (int*)(base + O_CNT); }
  __device__ __forceinline__ int* nrb() const { return (int*)(base + O_NRB); }
  __device__ __forceinline__ int* blk_e() const { return (int*)(base + O_BLKE); }
  __device__ __forceinline__ int* erb() const { return (int*)(base + O_ERB); }
  __device__ __forceinline__ int* eidx() const { return (int*)(base + O_EIDX); }
  __device__ __forceinline__ int* pos() const { return (int*)(base + O_POS); }
  __device__ __forceinline__ int* row_tok() const { return (int*)(base + O_RTOK); }
};
__device__ __forceinline__ WS make_ws(unsigned char* b) { WS w; w.base = b; return w; }

__device__ __forceinline__ float sigmoidf_(float v) { return __builtin_amdgcn_rcpf(1.f + __builtin_amdgcn_exp2f(-1.4426950408889634f * v)); }
__device__ __forceinline__ float siluf_(float v) { return v * __builtin_amdgcn_rcpf(1.f + __builtin_amdgcn_exp2f(-1.4426950408889634f * v)); }
__device__ __forceinline__ float gelu_tanh(float v) { const float u = 0.7978845608028654f * (v + 0.044715f * v * v * v); return v * (1.f - __builtin_amdgcn_rcpf(1.f + __builtin_amdgcn_exp2f(2.f * 1.4426950408889634f * u))); }
__device__ __forceinline__ float slope_a(int hq) { return 0.70710678118654752f * __uint_as_float((unsigned)(127 - hq) << 23); }
__device__ __forceinline__ float slope_b(int h) { return __uint_as_float((unsigned)(126 - h) << 23); }
template <int CTRL> __device__ __forceinline__ int dpp_i(int v) { return __builtin_amdgcn_update_dpp(0, v, CTRL, 0xf, 0xf, true); }
template <int CTRL> __device__ __forceinline__ float dpp_f(float v) { return __builtin_bit_cast(float, __builtin_amdgcn_update_dpp(0, __builtin_bit_cast(int, v), CTRL, 0xf, 0xf, true)); }
__device__ __forceinline__ void swap16_f(float v, float& a, float& b) { const auto r = __builtin_amdgcn_permlane16_swap(__builtin_bit_cast(unsigned, v), __builtin_bit_cast(unsigned, v), false, false); a = __builtin_bit_cast(float, r[0]); b = __builtin_bit_cast(float, r[1]); }
__device__ __forceinline__ void swap32_f(float v, float& a, float& b) { const auto r = __builtin_amdgcn_permlane32_swap(__builtin_bit_cast(unsigned, v), __builtin_bit_cast(unsigned, v), false, false); a = __builtin_bit_cast(float, r[0]); b = __builtin_bit_cast(float, r[1]); }
__device__ __forceinline__ void swap16_i(int v, int& a, int& b) { const auto r = __builtin_amdgcn_permlane16_swap((unsigned)v, (unsigned)v, false, false); a = (int)r[0]; b = (int)r[1]; }
__device__ __forceinline__ void swap32_i(int v, int& a, int& b) { const auto r = __builtin_amdgcn_permlane32_swap((unsigned)v, (unsigned)v, false, false); a = (int)r[0]; b = (int)r[1]; }
__device__ __forceinline__ float xsum32(float v) { return v + __shfl_xor(v, 32); }
__device__ __forceinline__ float xmax32(float v) { return fmaxf(v, __shfl_xor(v, 32)); }
__device__ __forceinline__ float wave_sum(float v) {
#pragma unroll
  for (int o = 1; o < 64; o <<= 1) v += __shfl_xor(v, o);
  return v;
}
__device__ __forceinline__ float wave_max(float v) {
#pragma unroll
  for (int o = 1; o < 64; o <<= 1) v = fmaxf(v, __shfl_xor(v, o));
  return v;
}
__device__ __forceinline__ void wave_argmax(float& v, int& idx) {
#pragma unroll
  for (int o = 1; o < 64; o <<= 1) {
    const float ov = __shfl_xor(v, o); const int oi = __shfl_xor(idx, o);
    if (ov > v || (ov == v && oi < idx)) { v = ov; idx = oi; }
  }
}
__device__ __forceinline__ void wave_argmax3(float& v, int& idx, float& pay) {
#pragma unroll
  for (int o = 1; o < 64; o <<= 1) {
    const float ov = __shfl_xor(v, o); const int oi = __shfl_xor(idx, o); const float op = __shfl_xor(pay, o);
    if (ov > v || (ov == v && oi < idx)) { v = ov; idx = oi; pay = op; }
  }
}
#define LDS_FENCE() asm volatile("s_waitcnt lgkmcnt(0)" ::: "memory")

constexpr int A_PITCH = 80, ST_A = 128 * A_PITCH, ST_B = 32 * 256, STAGE = ST_A + ST_B, GEMM_LDS = 2 * STAGE;
template <class AL, class BL>
__device__ __forceinline__ void gemm_core(unsigned char* lds, f32x16 (&acc)[2][2], int m0, int n0, int M, int N, int K, AL aload, BL bload) {
  int tid = threadIdx.x; asm volatile("" : "+v"(tid));
  const int lane = tid & 63, w = tid >> 6, wr = w >> 1, wc = w & 1;
#pragma unroll
  for (int i = 0; i < 2; ++i)
#pragma unroll
    for (int j = 0; j < 2; ++j)
#pragma unroll
      for (int r = 0; r < 16; ++r) acc[i][j][r] = 0.f;
  __syncthreads();
  uint4 av[2]; float4 bv[4];
#define GEMM_GLOAD(k0) do { \
    _Pragma("unroll") for (int i = 0; i < 2; ++i) { const int id = tid + 256 * i, row = id >> 2, kc = id & 3; av[i] = aload(min(m0 + row, M - 1), (k0) + 8 * kc); } \
    _Pragma("unroll") for (int i = 0; i < 4; ++i) { const int id = tid + 256 * i, kr = id >> 5, nq = id & 31; bv[i] = bload((k0) + kr, min(n0 + 4 * nq, N - 4)); } } while (0)
#define GEMM_LSTORE(buf) do { unsigned char* As_ = lds + (buf) * STAGE; unsigned char* Bs_ = As_ + ST_A; \
    _Pragma("unroll") for (int i = 0; i < 2; ++i) { const int id = tid + 256 * i, row = id >> 2, kc = id & 3; *(uint4*)(As_ + row * A_PITCH + kc * 16) = av[i]; } \
    _Pragma("unroll") for (int i = 0; i < 4; ++i) { const int id = tid + 256 * i, kr = id >> 5, n = 4 * (id & 31); \
      uint2 v; v.x = pk2(bv[i].x, bv[i].y); v.y = pk2(bv[i].z, bv[i].w); \
      *(uint2*)(Bs_ + kr * 256 + (((n >> 5) ^ (kr & 3)) << 6) + (n & 31) * 2) = v; } } while (0)
  const int q4 = (lane >> 2) & 3, h = lane >> 5, nk = K >> 5;
  GEMM_GLOAD(0); GEMM_LSTORE(0);
  if (nk > 1) GEMM_GLOAD(32);
  __syncthreads();
#pragma unroll 1
  for (int kt = 0; kt < nk; ++kt) {
    const unsigned char* As = lds + (kt & 1) * STAGE; const unsigned char* Bs = As + ST_A;
#pragma unroll
    for (int ks = 0; ks < 2; ++ks) {
      bf16x8 a[2], b[2];
#pragma unroll
      for (int i = 0; i < 2; ++i) a[i] = *(const bf16x8*)(As + (wr * 64 + i * 32 + (lane & 31)) * A_PITCH + ks * 32 + h * 16);
#pragma unroll
      for (int j = 0; j < 2; ++j) {
        const int k = ks * 16 + 8 * h + q4;
        const unsigned char* pb = Bs + k * 256 + ((((wc * 2 + j)) ^ q4) << 6) + ((lane >> 4) & 1) * 32 + (lane & 3) * 8;
        const v4i16_t lo = __builtin_amdgcn_ds_read_tr16_b64_v4i16((LAS v4i16_t*)pb);
        const v4i16_t hi = __builtin_amdgcn_ds_read_tr16_b64_v4i16((LAS v4i16_t*)(pb + 4 * 256));
        b[j] = __builtin_shufflevector(lo, hi, 0, 1, 2, 3, 4, 5, 6, 7);
      }
#pragma unroll
      for (int i = 0; i < 2; ++i)
#pragma unroll
        for (int j = 0; j < 2; ++j) acc[i][j] = __builtin_amdgcn_mfma_f32_32x32x16_bf16(a[i], b[j], acc[i][j], 0, 0, 0);
    }
    if (kt + 1 < nk) { GEMM_LSTORE((kt + 1) & 1); if (kt + 2 < nk) GEMM_GLOAD((kt + 2) * 32); }
    __syncthreads();
  }
#undef GEMM_GLOAD
#undef GEMM_LSTORE
}
__device__ __forceinline__ float* epi_stage(const f32x16 (&acc)[2][2], unsigned char* lds) {
  int tid_ = threadIdx.x; asm volatile("" : "+v"(tid_));
  const int lane = tid_ & 63, w = tid_ >> 6;
  float* st = (float*)(lds + w * 16384);
#pragma unroll
  for (int i = 0; i < 2; ++i)
#pragma unroll
    for (int j = 0; j < 2; ++j)
#pragma unroll
      for (int r = 0; r < 16; ++r) st[(i * 32 + (r & 3) + 8 * (r >> 2) + 4 * (lane >> 5)) * 64 + j * 32 + (lane & 31)] = acc[i][j][r];
  LDS_FENCE();
  return st;
}
template <class F4>
__device__ __forceinline__ void epi_rows(const f32x16 (&acc)[2][2], unsigned char* lds, int m0, int n0, int M, int N, F4 f) {
  const int lane = threadIdx.x & 63, w = threadIdx.x >> 6, wr = w >> 1, wc = w & 1;
  const float* st = epi_stage(acc, lds);
#pragma unroll 2
  for (int it = 0; it < 16; ++it) {
    const int rl = it * 4 + (lane >> 4), cl = (lane & 15) * 4;
    const float4 v = *(const float4*)(st + rl * 64 + cl);
    const int row = m0 + wr * 64 + rl, col = n0 + wc * 64 + cl;
    if (row < M && col < N) f(row, col, v);
  }
}
template <class F4>
__device__ __forceinline__ void epi_pair_rows(const f32x16 (&acc)[2][2], unsigned char* lds, int m0, int h0, int M, F4 f) {
  const int lane = threadIdx.x & 63, w = threadIdx.x >> 6, wr = w >> 1, wc = w & 1;
  const float* st = epi_stage(acc, lds);
#pragma unroll 2
  for (int it = 0; it < 8; ++it) {
    const int rl = it * 8 + (lane >> 3), cl = (lane & 7) * 4;
    const float4 g = *(const float4*)(st + rl * 64 + cl), u = *(const float4*)(st + rl * 64 + 32 + cl);
    const int row = m0 + wr * 64 + rl;
    if (row < M) f(row, h0 + wc * 32 + cl, g, u);
  }
}
template <class AL, class BL, class EP>
__device__ __forceinline__ void gemm_tile_bf16(unsigned char* lds, int m0, int n0, int M, int N, int K, AL aload, BL bload, EP epi) {
  f32x16 acc[2][2];
  gemm_core(lds, acc, m0, n0, M, N, K, aload, bload);
  epi_rows(acc, lds, m0, n0, M, N, epi);
}
__device__ __forceinline__ void st_bf16x4(bf16* p, float4 v) { uint2 u; u.x = pk2(v.x, v.y); u.y = pk2(v.z, v.w); *(uint2*)p = u; }
__device__ __forceinline__ float4 ld_bf16x4(const bf16* p) { const uint2 u = *(const uint2*)p; return make_float4(__uint_as_float(u.x << 16), __uint_as_float(u.x & 0xffff0000u), __uint_as_float(u.y << 16), __uint_as_float(u.y & 0xffff0000u)); }
__device__ __forceinline__ float4 up_bf16x4(unsigned lo, unsigned hi) { return make_float4(__uint_as_float(lo << 16), __uint_as_float(lo & 0xffff0000u), __uint_as_float(hi << 16), __uint_as_float(hi & 0xffff0000u)); }
__device__ __forceinline__ float4 sig4(float4 v) { return make_float4(sigmoidf_(v.x), sigmoidf_(v.y), sigmoidf_(v.z), sigmoidf_(v.w)); }
__device__ __forceinline__ float4 mul4(float4 a, float4 b) { return make_float4(a.x * b.x, a.y * b.y, a.z * b.z, a.w * b.w); }
__device__ __forceinline__ float4 scale4(float4 a, float s) { return make_float4(a.x * s, a.y * s, a.z * s, a.w * s); }


constexpr int ST2_A = 256 * A_PITCH, ST2_B = 32 * 256, STAGE2 = ST2_A + ST2_B, GEMM2_LDS = 2 * STAGE2;
__device__ __forceinline__ uint2 to_bf16x4(float4 v) { uint2 r; r.x = pk2(v.x, v.y); r.y = pk2(v.z, v.w); return r; }
__device__ __forceinline__ uint2 to_bf16x4(uint2 v) { return v; }
template <class AR, class BL>
__device__ __forceinline__ void gemm256_core(unsigned char* lds, f32x16 (&acc)[4][2], int m0, int n0, int M, int N, int K, AR arow, BL bload) {
  int tid = threadIdx.x; asm volatile("" : "+v"(tid));
  const int lane = tid & 63, w = tid >> 6, wr = w >> 1, wc = w & 1;
#pragma unroll
  for (int i = 0; i < 4; ++i)
#pragma unroll
    for (int j = 0; j < 2; ++j)
#pragma unroll
      for (int r = 0; r < 16; ++r) acc[i][j][r] = 0.f;
  const bf16* ap0 = arow(min(m0 + ((tid) >> 2), M - 1)) + 8 * (tid & 3);
  const bf16* ap1 = arow(min(m0 + ((tid + 256) >> 2), M - 1)) + 8 * (tid & 3);
  const bf16* ap2 = arow(min(m0 + ((tid + 512) >> 2), M - 1)) + 8 * (tid & 3);
  const bf16* ap3 = arow(min(m0 + ((tid + 768) >> 2), M - 1)) + 8 * (tid & 3);
  __syncthreads();
  uint4 av0, av1, av2, av3; decltype(bload(0, 0)) bv0, bv1, bv2, bv3;
  const int bkr = tid >> 5, bcol = min(n0 + 4 * (tid & 31), N - 4);
#define G2_GLOAD(k0) do { av0 = *(const uint4*)(ap0 + (k0)); av1 = *(const uint4*)(ap1 + (k0)); av2 = *(const uint4*)(ap2 + (k0)); av3 = *(const uint4*)(ap3 + (k0)); \
    bv0 = bload((k0) + bkr, bcol); bv1 = bload((k0) + bkr + 8, bcol); bv2 = bload((k0) + bkr + 16, bcol); bv3 = bload((k0) + bkr + 24, bcol); } while (0)
#define G2_LSTORE(buf) do { unsigned char* As_ = lds + (buf) * STAGE2 + (tid >> 2) * A_PITCH + (tid & 3) * 16; \
    *(uint4*)(As_) = av0; *(uint4*)(As_ + 64 * A_PITCH) = av1; *(uint4*)(As_ + 128 * A_PITCH) = av2; *(uint4*)(As_ + 192 * A_PITCH) = av3; \
    const int n_ = 4 * (tid & 31); unsigned char* Bs_ = lds + (buf) * STAGE2 + ST2_A + bkr * 256 + (((n_ >> 5) ^ (bkr & 3)) << 6) + (n_ & 31) * 2; \
    *(uint2*)(Bs_) = to_bf16x4(bv0); *(uint2*)(Bs_ + 8 * 256) = to_bf16x4(bv1); *(uint2*)(Bs_ + 16 * 256) = to_bf16x4(bv2); *(uint2*)(Bs_ + 24 * 256) = to_bf16x4(bv3); } while (0)
  const int q4 = (lane >> 2) & 3, h = lane >> 5, nk = K >> 5;
  G2_GLOAD(0); G2_LSTORE(0);
  if (nk > 1) G2_GLOAD(32);
  __syncthreads();
#pragma unroll 1
  for (int kt = 0; kt < nk; ++kt) {
    const unsigned char* As = lds + (kt & 1) * STAGE2; const unsigned char* Bs = As + ST2_A;
#pragma unroll
    for (int ks = 0; ks < 2; ++ks) {
      bf16x8 a[4], b[2];
#pragma unroll
      for (int i = 0; i < 4; ++i) a[i] = *(const bf16x8*)(As + (wr * 128 + i * 32 + (lane & 31)) * A_PITCH + ks * 32 + h * 16);
#pragma unroll
      for (int j = 0; j < 2; ++j) {
        const int k = ks * 16 + 8 * h + q4;
        const unsigned char* pb = Bs + k * 256 + ((((wc * 2 + j)) ^ q4) << 6) + ((lane >> 4) & 1) * 32 + (lane & 3) * 8;
        const v4i16_t lo = __builtin_amdgcn_ds_read_tr16_b64_v4i16((LAS v4i16_t*)pb);
        const v4i16_t hi = __builtin_amdgcn_ds_read_tr16_b64_v4i16((LAS v4i16_t*)(pb + 4 * 256));
        b[j] = __builtin_shufflevector(lo, hi, 0, 1, 2, 3, 4, 5, 6, 7);
      }
#pragma unroll
      for (int i = 0; i < 4; ++i)
#pragma unroll
        for (int j = 0; j < 2; ++j) acc[i][j] = __builtin_amdgcn_mfma_f32_32x32x16_bf16(a[i], b[j], acc[i][j], 0, 0, 0);
    }
    if (kt + 1 < nk) { G2_LSTORE((kt + 1) & 1); if (kt + 2 < nk) G2_GLOAD((kt + 2) * 32); }
    __syncthreads();
  }
#undef G2_GLOAD
#undef G2_LSTORE
}
template <class AR, class BL>
__device__ __forceinline__ void gemm256_core_pf2(unsigned char* lds, f32x16 (&acc)[4][2], int m0, int n0, int M, int N, int K, AR arow, BL bload) {
  int tid = threadIdx.x; asm volatile("" : "+v"(tid));
  const int lane = tid & 63, w = tid >> 6, wr = w >> 1, wc = w & 1;
#pragma unroll
  for (int i = 0; i < 4; ++i)
#pragma unroll
    for (int j = 0; j < 2; ++j)
#pragma unroll
      for (int r = 0; r < 16; ++r) acc[i][j][r] = 0.f;
  const bf16* ap0 = arow(min(m0 + ((tid) >> 2), M - 1)) + 8 * (tid & 3);
  const bf16* ap1 = arow(min(m0 + ((tid + 256) >> 2), M - 1)) + 8 * (tid & 3);
  const bf16* ap2 = arow(min(m0 + ((tid + 512) >> 2), M - 1)) + 8 * (tid & 3);
  const bf16* ap3 = arow(min(m0 + ((tid + 768) >> 2), M - 1)) + 8 * (tid & 3);
  __syncthreads();
  uint4 a00, a01, a02, a03, a10, a11, a12, a13; decltype(bload(0, 0)) b00, b01, b02, b03, b10, b11, b12, b13;
  const int bkr = tid >> 5, bcol = min(n0 + 4 * (tid & 31), N - 4);
#define P2_GLOAD(S, k0) do { a##S##0 = *(const uint4*)(ap0 + (k0)); a##S##1 = *(const uint4*)(ap1 + (k0)); a##S##2 = *(const uint4*)(ap2 + (k0)); a##S##3 = *(const uint4*)(ap3 + (k0)); \
    b##S##0 = bload((k0) + bkr, bcol); b##S##1 = bload((k0) + bkr + 8, bcol); b##S##2 = bload((k0) + bkr + 16, bcol); b##S##3 = bload((k0) + bkr + 24, bcol); } while (0)
#define P2_LSTORE(S, buf) do { unsigned char* As_ = lds + (buf) * STAGE2 + (tid >> 2) * A_PITCH + (tid & 3) * 16; \
    *(uint4*)(As_) = a##S##0; *(uint4*)(As_ + 64 * A_PITCH) = a##S##1; *(uint4*)(As_ + 128 * A_PITCH) = a##S##2; *(uint4*)(As_ + 192 * A_PITCH) = a##S##3; \
    const int n_ = 4 * (tid & 31); unsigned char* Bs_ = lds + (buf) * STAGE2 + ST2_A + bkr * 256 + (((n_ >> 5) ^ (bkr & 3)) << 6) + (n_ & 31) * 2; \
    *(uint2*)(Bs_) = to_bf16x4(b##S##0); *(uint2*)(Bs_ + 8 * 256) = to_bf16x4(b##S##1); *(uint2*)(Bs_ + 16 * 256) = to_bf16x4(b##S##2); *(uint2*)(Bs_ + 24 * 256) = to_bf16x4(b##S##3); } while (0)
  const int q4 = (lane >> 2) & 3, h = lane >> 5, nk = K >> 5;
#define P2_COMPUTE(buf) do { const unsigned char* As = lds + (buf) * STAGE2; const unsigned char* Bs = As + ST2_A; \
    _Pragma("unroll") for (int ks = 0; ks < 2; ++ks) { \
      bf16x8 a[4], b[2]; \
      _Pragma("unroll") for (int i = 0; i < 4; ++i) a[i] = *(const bf16x8*)(As + (wr * 128 + i * 32 + (lane & 31)) * A_PITCH + ks * 32 + h * 16); \
      _Pragma("unroll") for (int j = 0; j < 2; ++j) { \
        const int k = ks * 16 + 8 * h + q4; \
        const unsigned char* pb = Bs + k * 256 + ((((wc * 2 + j)) ^ q4) << 6) + ((lane >> 4) & 1) * 32 + (lane & 3) * 8; \
        const v4i16_t lo = __builtin_amdgcn_ds_read_tr16_b64_v4i16((LAS v4i16_t*)pb); \
        const v4i16_t hi = __builtin_amdgcn_ds_read_tr16_b64_v4i16((LAS v4i16_t*)(pb + 4 * 256)); \
        b[j] = __builtin_shufflevector(lo, hi, 0, 1, 2, 3, 4, 5, 6, 7); } \
      _Pragma("unroll") for (int i = 0; i < 4; ++i) \
        _Pragma("unroll") for (int j = 0; j < 2; ++j) acc[i][j] = __builtin_amdgcn_mfma_f32_32x32x16_bf16(a[i], b[j], acc[i][j], 0, 0, 0); } } while (0)
  P2_GLOAD(0, 0); P2_LSTORE(0, 0); P2_GLOAD(1, 32); P2_GLOAD(0, 64);
  __syncthreads();
#pragma unroll 1
  for (int kt = 0; kt < nk; kt += 2) {
    P2_COMPUTE(0);
    P2_LSTORE(1, 1); if (kt + 3 < nk) P2_GLOAD(1, (kt + 3) * 32);
    __syncthreads();
    P2_COMPUTE(1);
    if (kt + 2 < nk) { P2_LSTORE(0, 0); if (kt + 4 < nk) P2_GLOAD(0, (kt + 4) * 32); }
    __syncthreads();
  }
#undef P2_GLOAD
#undef P2_LSTORE
#undef P2_COMPUTE
}
template <class F4>
__device__ __forceinline__ void epi256_rows(const f32x16 (&acc)[4][2], unsigned char* lds, int m0, int n0, int M, int N, F4 f) {
  int tid_ = threadIdx.x; asm volatile("" : "+v"(tid_));
  const int lane = tid_ & 63, w = tid_ >> 6, wr = w >> 1, wc = w & 1;
  float* st = (float*)(lds + w * 16384);
#pragma unroll
  for (int hf = 0; hf < 2; ++hf) {
#pragma unroll
    for (int i = 0; i < 2; ++i)
#pragma unroll
      for (int j = 0; j < 2; ++j)
#pragma unroll
        for (int r = 0; r < 16; ++r) st[(i * 32 + (r & 3) + 8 * (r >> 2) + 4 * (lane >> 5)) * 64 + j * 32 + (lane & 31)] = acc[2 * hf + i][j][r];
    LDS_FENCE();
#pragma unroll 8
    for (int it = 0; it < 16; ++it) {
      const int rl = it * 4 + (lane >> 4), cl = (lane & 15) * 4;
      const float4 v = *(const float4*)(st + rl * 64 + cl);
      const int row = m0 + wr * 128 + hf * 64 + rl, col = n0 + wc * 64 + cl;
      if (row < M && col < N) f(row, col, v);
    }
    LDS_FENCE();
  }
}
template <class PRE, class F4>
__device__ __forceinline__ void epi256_rows_pre(const f32x16 (&acc)[4][2], unsigned char* lds, int m0, int n0, int M, int N, PRE pre, F4 f) {
  int tid_ = threadIdx.x; asm volatile("" : "+v"(tid_));
  const int lane = tid_ & 63, w = tid_ >> 6, wr = w >> 1, wc = w & 1;
  float* st = (float*)(lds + w * 16384);
  const int cl = (lane & 15) * 4, col = n0 + wc * 64 + cl;
#pragma unroll
  for (int hf = 0; hf < 2; ++hf) {
    uint4 pv[16];
#pragma unroll
    for (int it = 0; it < 16; ++it) { const int row = m0 + wr * 128 + hf * 64 + it * 4 + (lane >> 4); pv[it] = pre(min(row, M - 1), min(col, N - 4)); }
#pragma unroll
    for (int i = 0; i < 2; ++i)
#pragma unroll
      for (int j = 0; j < 2; ++j)
#pragma unroll
        for (int r = 0; r < 16; ++r) st[(i * 32 + (r & 3) + 8 * (r >> 2) + 4 * (lane >> 5)) * 64 + j * 32 + (lane & 31)] = acc[2 * hf + i][j][r];
    LDS_FENCE();
#pragma unroll
    for (int it = 0; it < 16; ++it) {
      const int rl = it * 4 + (lane >> 4);
      const float4 v = *(const float4*)(st + rl * 64 + cl);
      const int row = m0 + wr * 128 + hf * 64 + rl;
      if (row < M && col < N) f(row, col, v, pv[it]);
    }
    LDS_FENCE();
  }
}
template <class F4>
__device__ __forceinline__ void epi256_pair_rows(const f32x16 (&acc)[4][2], unsigned char* lds, int m0, int h0, int M, F4 f) {
  int tid_ = threadIdx.x; asm volatile("" : "+v"(tid_));
  const int lane = tid_ & 63, w = tid_ >> 6, wr = w >> 1, wc = w & 1;
  float* st = (float*)(lds + w * 16384);
#pragma unroll
  for (int hf = 0; hf < 2; ++hf) {
#pragma unroll
    for (int i = 0; i < 2; ++i)
#pragma unroll
      for (int j = 0; j < 2; ++j)
#pragma unroll
        for (int r = 0; r < 16; ++r) st[(i * 32 + (r & 3) + 8 * (r >> 2) + 4 * (lane >> 5)) * 64 + j * 32 + (lane & 31)] = acc[2 * hf + i][j][r];
    LDS_FENCE();
#pragma unroll 2
    for (int it = 0; it < 8; ++it) {
      const int rl = it * 8 + (lane >> 3), cl = (lane & 7) * 4;
      const float4 g = *(const float4*)(st + rl * 64 + cl), u = *(const float4*)(st + rl * 64 + 32 + cl);
      const int row = m0 + wr * 128 + hf * 64 + rl;
      if (row < M) f(row, h0 + wc * 32 + cl, g, u);
    }
    LDS_FENCE();
  }
}
template <class AR, class BL, class PRE, class EP>
__device__ __forceinline__ void gemm256_tile_pre(unsigned char* lds, int m0, int n0, int M, int N, int K, AR arow, BL bload, PRE pre, EP epi) {
  f32x16 acc[4][2];
  gemm256_core_pf2(lds, acc, m0, n0, M, N, K, arow, bload);
  epi256_rows_pre(acc, lds, m0, n0, M, N, pre, epi);
}
template <class AR, class BL, class PRE, class EP>
__device__ __forceinline__ void gemm256_tile_pre_pf2(unsigned char* lds, int m0, int n0, int M, int N, int K, AR arow, BL bload, PRE pre, EP epi) {
  f32x16 acc[4][2];
  gemm256_core_pf2(lds, acc, m0, n0, M, N, K, arow, bload);
  epi256_rows_pre(acc, lds, m0, n0, M, N, pre, epi);
}
template <class AR, class BL, class EP>
__device__ __forceinline__ void gemm256_tile(unsigned char* lds, int m0, int n0, int M, int N, int K, AR arow, BL bload, EP epi) {
  f32x16 acc[4][2];
  gemm256_core_pf2(lds, acc, m0, n0, M, N, K, arow, bload);
  epi256_rows(acc, lds, m0, n0, M, N, epi);
}

template <class LD>
__device__ __forceinline__ void rms_mod_row_t(LD ld, const float* g, const float* sc, const float* sh, bf16* orow, int lane) {
  float4 v[4]; float s = 0.f;
#pragma unroll
  for (int j = 0; j < 4; ++j) { v[j] = ld(lane + 64 * j); s += v[j].x * v[j].x + v[j].y * v[j].y + v[j].z * v[j].z + v[j].w * v[j].w; }
  s = wave_sum(s);
  const float rs = rsqrtf(s * (1.f / D) + 1e-6f);
#pragma unroll
  for (int j = 0; j < 4; ++j) {
    const float4 gg = ((const float4*)g)[lane + 64 * j], cc = ((const float4*)sc)[lane + 64 * j], hh = ((const float4*)sh)[lane + 64 * j];
    float4 o;
    o.x = v[j].x * rs * gg.x * (1.f + cc.x) + hh.x; o.y = v[j].y * rs * gg.y * (1.f + cc.y) + hh.y;
    o.z = v[j].z * rs * gg.z * (1.f + cc.z) + hh.z; o.w = v[j].w * rs * gg.w * (1.f + cc.w) + hh.w;
    uint2 ov; ov.x = pk2(o.x, o.y); ov.y = pk2(o.z, o.w); ((uint2*)orow)[lane + 64 * j] = ov;
  }
}
__device__ __forceinline__ float4 bf4_to_f4(uint2 e) { return make_float4(__uint_as_float(e.x << 16), __uint_as_float(e.x & 0xffff0000u), __uint_as_float(e.y << 16), __uint_as_float(e.y & 0xffff0000u)); }
__device__ __forceinline__ void rms_mod_row(const float* xr, const float* g, const float* sc, const float* sh, bf16* orow, int lane) {
  rms_mod_row_t([&](int i) { return ((const float4*)xr)[i]; }, g, sc, sh, orow, lane);
}
__device__ __forceinline__ void rms_mod_row_b(const bf16* xr, const float* g, const float* sc, const float* sh, bf16* orow, int lane) {
  rms_mod_row_t([&](int i) { return bf4_to_f4(((const uint2*)xr)[i]); }, g, sc, sh, orow, lane);
}

constexpr float LOG2E = 1.4426950408889634f;
constexpr int KL_PITCH = 144, KL_BYTES = 64 * KL_PITCH, VL_BYTES = 64 * 128;
constexpr int NSA_OUT_OFF = KL_BYTES + VL_BYTES + 16384 + 512 + 32 + 144, ATT_LDS = NSA_OUT_OFF + 32 * 256 * 4;
struct StageRegs { uint4 k0, k1, v0, v1; };
__device__ __forceinline__ void stage_load(const bf16* Kg, const bf16* Vg, StageRegs& r, int tid) {
  r.k0 = ((const uint4*)Kg)[tid]; r.k1 = ((const uint4*)Kg)[tid + 256]; r.v0 = ((const uint4*)Vg)[tid]; r.v1 = ((const uint4*)Vg)[tid + 256];
}
__device__ __forceinline__ void stage_store(unsigned char* Kl, unsigned char* Vl, const StageRegs& r, int tid) {
  { const int id = tid, row = id >> 3, c8 = id & 7;
    *(uint4*)(Kl + row * KL_PITCH + c8 * 16) = r.k0;
    *(uint4*)(Vl + row * 128 + ((((c8 >> 2) ^ ((row >> 1) & 1))) << 6) + (c8 & 3) * 16) = r.v0; }
  { const int id = tid + 256, row = id >> 3, c8 = id & 7;
    *(uint4*)(Kl + row * KL_PITCH + c8 * 16) = r.k1;
    *(uint4*)(Vl + row * 128 + ((((c8 >> 2) ^ ((row >> 1) & 1))) << 6) + (c8 & 3) * 16) = r.v1; }
}
__device__ __forceinline__ void qk_tile(const unsigned char* Kl, const bf16x8 (&qf)[4], f32x16 (&Sx)[2], int lane) {
#pragma unroll
  for (int kb = 0; kb < 2; ++kb)
#pragma unroll
    for (int r = 0; r < 16; ++r) Sx[kb][r] = 0.f;
#pragma unroll
  for (int ks = 0; ks < 4; ++ks) {
    bf16x8 a[2];
#pragma unroll
    for (int kb = 0; kb < 2; ++kb) a[kb] = *(const bf16x8*)(Kl + (kb * 32 + (lane & 31)) * KL_PITCH + ks * 32 + (lane >> 5) * 16);
#pragma unroll
    for (int kb = 0; kb < 2; ++kb) Sx[kb] = __builtin_amdgcn_mfma_f32_32x32x16_bf16(a[kb], qf[ks], Sx[kb], 0, 0, 0);
  }
}
__device__ __forceinline__ void pv_tile(const unsigned char* Vl, const f32x16 (&P)[2], f32x16 (&O)[2], int lane) {
  const int h = lane >> 5, q = (lane >> 2) & 3, pp = lane & 3, g16 = (lane >> 4) & 1;
#pragma unroll
  for (int kb = 0; kb < 2; ++kb)
#pragma unroll
    for (int s2 = 0; s2 < 2; ++s2) {
      uint4 pk; pk.x = pk2(P[kb][8 * s2 + 0], P[kb][8 * s2 + 1]); pk.y = pk2(P[kb][8 * s2 + 2], P[kb][8 * s2 + 3]);
      pk.z = pk2(P[kb][8 * s2 + 4], P[kb][8 * s2 + 5]); pk.w = pk2(P[kb][8 * s2 + 6], P[kb][8 * s2 + 7]);
      const bf16x8 pf = __builtin_bit_cast(bf16x8, pk);
#pragma unroll
      for (int db = 0; db < 2; ++db) {
        const unsigned char* pa = Vl + (kb * 32 + 16 * s2 + 4 * h + q) * 128 + ((db ^ (q >> 1)) << 6) + (16 * g16 + 4 * pp) * 2;
        const v4i16_t lo = __builtin_amdgcn_ds_read_tr16_b64_v4i16((LAS v4i16_t*)pa);
        const v4i16_t hi = __builtin_amdgcn_ds_read_tr16_b64_v4i16((LAS v4i16_t*)(pa + 8 * 128));
        const bf16x8 vf = __builtin_shufflevector(lo, hi, 0, 1, 2, 3, 4, 5, 6, 7);
        O[db] = __builtin_amdgcn_mfma_f32_32x32x16_bf16(vf, pf, O[db], 0, 0, 0);
      }
    }
}
__device__ __forceinline__ void mfma_settle(f32x16 (&Sx)[2], float& slopek) {
  float e0 = Sx[0][15], e1 = Sx[1][15];
  asm volatile("s_nop 7\n\ts_nop 7\n\ts_nop 3" : "+v"(slopek), "+v"(e0), "+v"(e1));
  Sx[0][15] = e0; Sx[1][15] = e1;
}
template <int MODE, int I>
struct BiasStep {
  static __device__ __forceinline__ void run(f32x16 (&Sx)[2], float slopek, int lim_hi, int lim_lo) {
    constexpr int kb = I >> 4, r = I & 15, c = kb * 32 + (r & 3) + 8 * (r >> 2);
    float s;
    asm("v_fmamk_f32 %0, %1, %2, %3" : "=v"(s) : "v"(slopek), "n"(__builtin_bit_cast(int, (float)c)), "v"(Sx[kb][r]));
    if (MODE & 1) s = (c > lim_hi) ? -INFINITY : s;
    if (MODE & 2) s = (c <= lim_lo) ? -INFINITY : s;
    Sx[kb][r] = s;
    BiasStep<MODE, I + 1>::run(Sx, slopek, lim_hi, lim_lo);
  }
};
template <int MODE>
struct BiasStep<MODE, 32> { static __device__ __forceinline__ void run(f32x16 (&)[2], float, int, int) {} };
template <int MODE>
__device__ __forceinline__ void bias_mask(f32x16 (&Sx)[2], float slopek, int lim_hi, int lim_lo) {
  mfma_settle(Sx, slopek);
  BiasStep<MODE, 0>::run(Sx, slopek, lim_hi, lim_lo);
}
__device__ __forceinline__ float vmax3(float a, float b, float c) { float d; asm("v_max3_f32 %0, %1, %2, %3" : "=v"(d) : "v"(a), "v"(b), "v"(c)); return d; }
__device__ __forceinline__ float tile_max(const f32x16 (&Sx)[2]) {
  float m0 = vmax3(Sx[0][0], Sx[0][1], Sx[0][2]), m1 = vmax3(Sx[1][0], Sx[1][1], Sx[1][2]);
  m0 = vmax3(m0, Sx[0][3], Sx[0][4]); m1 = vmax3(m1, Sx[1][3], Sx[1][4]);
  m0 = vmax3(m0, Sx[0][5], Sx[0][6]); m1 = vmax3(m1, Sx[1][5], Sx[1][6]);
  m0 = vmax3(m0, Sx[0][7], Sx[0][8]); m1 = vmax3(m1, Sx[1][7], Sx[1][8]);
  m0 = vmax3(m0, Sx[0][9], Sx[0][10]); m1 = vmax3(m1, Sx[1][9], Sx[1][10]);
  m0 = vmax3(m0, Sx[0][11], Sx[0][12]); m1 = vmax3(m1, Sx[1][11], Sx[1][12]);
  m0 = vmax3(m0, Sx[0][13], Sx[0][14]); m1 = vmax3(m1, Sx[1][13], Sx[1][14]);
  return vmax3(m0, m1, fmaxf(Sx[0][15], Sx[1][15]));
}
__device__ __forceinline__ void exp_sum2(float& s0, float& s1, float& l0, float& l1, float t) {
  asm("v_add_f32 %0, %0, %4\n\tv_add_f32 %1, %1, %4\n\tv_exp_f32 %0, %0\n\tv_exp_f32 %1, %1\n\tv_add_f32 %2, %2, %0\n\tv_add_f32 %3, %3, %1"
      : "+v"(s0), "+v"(s1), "+v"(l0), "+v"(l1) : "v"(t));
}
__device__ __forceinline__ void exp_scale2(float& s0, float& s1, float t, float inv) {
  asm("v_add_f32 %0, %0, %2\n\tv_add_f32 %1, %1, %2\n\tv_exp_f32 %0, %0\n\tv_exp_f32 %1, %1\n\tv_mul_f32 %0, %0, %3\n\tv_mul_f32 %1, %1, %3\n\ts_nop 1"
      : "+v"(s0), "+v"(s1) : "v"(t), "v"(inv));
}
__device__ __forceinline__ void online_update(f32x16 (&Sx)[2], f32x16 (&O)[2], float& m, float& l, float sbh) {
  const float mx = xmax32(tile_max(Sx) + sbh);
  if (__ballot(mx > m + 8.f) != 0ull) {
    const float mn = fmaxf(m, mx);
    const float ms = (mn == -INFINITY) ? 0.f : mn;
    const float alpha = __builtin_amdgcn_exp2f(m - ms);
    l *= alpha; m = mn;
#pragma unroll
    for (int db = 0; db < 2; ++db)
#pragma unroll
      for (int r = 0; r < 16; ++r) O[db][r] *= alpha;
  }
  const float t = sbh - ((m == -INFINITY) ? 0.f : m);
  float ls0 = 0.f, ls1 = 0.f;
#pragma unroll
  for (int r = 0; r < 16; ++r) {
    float p0 = Sx[0][r], p1 = Sx[1][r];
    exp_sum2(p0, p1, ls0, ls1, t);
    Sx[0][r] = p0; Sx[1][r] = p1;
  }
  l += ls0 + ls1;
}
template <class OFF, class BODY>
__device__ __forceinline__ void tile_loop(unsigned char* Kl, unsigned char* Vl, const bf16* Kg, const bf16* Vg, int n, int tid, OFF off, BODY body) {
  StageRegs s0, s1;
  s0.k0 = s0.k1 = s0.v0 = s0.v1 = make_uint4(0, 0, 0, 0); s1 = s0;
  if (n > 0) { const size_t o = off(0); stage_load(Kg + o, Vg + o, s0, tid); }
  if (n > 1) { const size_t o = off(1); stage_load(Kg + o, Vg + o, s1, tid); }
  for (int it = 0; it < n; it += 2) {
    __syncthreads(); stage_store(Kl, Vl, s0, tid); __syncthreads();
    if (it + 2 < n) { const size_t o = off(it + 2); stage_load(Kg + o, Vg + o, s0, tid); }
    body(it);
    if (it + 1 < n) {
      __syncthreads(); stage_store(Kl, Vl, s1, tid); __syncthreads();
      if (it + 3 < n) { const size_t o = off(it + 3); stage_load(Kg + o, Vg + o, s1, tid); }
      body(it + 1);
    }
  }
}
__device__ __forceinline__ int nvalid_cmp(int s) { return s >= 31 ? min(NC, (s - 31) / 16 + 1) : 0; }

__device__ __forceinline__ void nsa_unit(const WS& w, unsigned char* lds, int unit) {
  int tid = threadIdx.x; asm volatile("" : "+v"(tid));
  const int lane = tid & 63, wv = tid >> 6, h = lane >> 5;
  unsigned char* Kl = lds; unsigned char* Vl = lds + KL_BYTES;
  float* imp = (float*)(lds + KL_BYTES + VL_BYTES);
  unsigned short* selm = (unsigned short*)(lds + KL_BYTES + VL_BYTES + 16384);
  unsigned* uni = (unsigned*)(lds + KL_BYTES + VL_BYTES + 16384 + 512);
  unsigned char* tlist = lds + KL_BYTES + VL_BYTES + 16384 + 512 + 32;
  const int pairi = unit >> 1, bh = pairi >> 7, cc = pairi & 127;
  const int c32 = ((unit ^ (unit >> 9)) & 1) ? (255 - cc) : cc;
  const int b = bh >> 1, kvh = bh & 1;
  const int s0 = c32 * 32, cur = s0 >> 6;
  const int col = lane & 31, qi = col >> 2, g = col & 3, hq = kvh * 4 + g;
  const int sq = s0 + wv * 8 + qi, t = b * S + sq, ql = sq & 63;
  const float slope2 = slope_a(hq) * LOG2E;
  bf16x8 qf[4];
#pragma unroll
  for (int ks = 0; ks < 4; ++ks) qf[ks] = *(const bf16x8*)(w.qa() + (size_t)t * 512 + hq * 64 + ks * 16 + 8 * h);
  const bf16* kcg = w.kcb() + (size_t)(0 * 4 + bh) * 512 * 64;
  const bf16* vcg = w.kcb() + (size_t)(1 * 4 + bh) * 512 * 64;
  const bf16* ksg = w.kva() + (size_t)((2 * 2 + b) * 2 + kvh) * S * 64;
  const bf16* vsg = w.kva() + (size_t)((3 * 2 + b) * 2 + kvh) * S * 64;
  const bf16* kwg = w.kva() + (size_t)((4 * 2 + b) * 2 + kvh) * S * 64;
  const bf16* vwg = w.kva() + (size_t)((5 * 2 + b) * 2 + kvh) * S * 64;
  float* outl = (float*)(lds + NSA_OUT_OFF) + tid;
#pragma unroll
  for (int i = 0; i < 16; ++i) imp[wv * 1024 + lane + 64 * i] = 0.f;
  if (tid < 8) uni[tid] = 0u;
  f32x16 Sx[2], O[2];
  {
    const int ntc = (nvalid_cmp(s0 + 31) + 63) >> 6;
    const int nvq = nvalid_cmp(sq);
    float m = -INFINITY, l = 0.f;
    const float slope16 = slope2 * 16.f;
    tile_loop(Kl, Vl, kcg, vcg, ntc, tid, [&](int i) { return (size_t)i * 4096; }, [&](int ct) {
      qk_tile(Kl, qf, Sx, lane);
      const float sbc = slope2 * (16.f * (float)(ct * 64 + 4 * h) + 15.5f - (float)sq);
      bias_mask<1>(Sx, slope16, nvq - ct * 64 - 4 * h - 1, 0);
      const float mn = fmaxf(m, xmax32(tile_max(Sx) + sbc));
      const float ms = (mn == -INFINITY) ? 0.f : mn;
      const float tc = sbc - ms;
      float ls0 = 0.f, ls1 = 0.f;
#pragma unroll
      for (int r = 0; r < 16; ++r) { float p0 = Sx[0][r], p1 = Sx[1][r]; exp_sum2(p0, p1, ls0, ls1, tc); }
      l = l * __builtin_amdgcn_exp2f(m - ms) + (ls0 + ls1); m = mn;
    });
    l = xsum32(l);
    const float ms = (m == -INFINITY) ? 0.f : m;
    const float inv = 1.f / fmaxf(l, 1e-30f);
#pragma unroll
    for (int db = 0; db < 2; ++db)
#pragma unroll
      for (int r = 0; r < 16; ++r) O[db][r] = 0.f;
    tile_loop(Kl, Vl, kcg, vcg, ntc, tid, [&](int i) { return (size_t)i * 4096; }, [&](int ct) {
      qk_tile(Kl, qf, Sx, lane);
      bias_mask<1>(Sx, slope16, nvq - ct * 64 - 4 * h - 1, 0);
      const float tc = slope2 * (16.f * (float)(ct * 64 + 4 * h) + 15.5f - (float)sq) - ms;
#pragma unroll
      for (int r = 0; r < 16; ++r) { float p0 = Sx[0][r], p1 = Sx[1][r]; exp_scale2(p0, p1, tc, inv); Sx[0][r] = p0; Sx[1][r] = p1; }
      pv_tile(Vl, Sx, O, lane);
      float* impq = imp + (wv * 8 + qi) * 128;
#pragma unroll
      for (int kb = 0; kb < 2; ++kb)
#pragma unroll
        for (int a = 0; a < 4; ++a) {
          float pq[4];
#pragma unroll
          for (int u = 0; u < 4; ++u) { float v = Sx[kb][4 * a + u]; v += dpp_f<0xB1>(v); v += dpp_f<0x4E>(v); pq[u] = v; }
          const int jb = ct * 16 + kb * 8 + 2 * a + h;
          if (g == 0) {
            atomicAdd(&impq[jb], pq[0] + pq[0] + pq[1] + pq[1] + pq[2] + pq[2] + pq[3]);
            if (jb + 1 < 128) atomicAdd(&impq[jb + 1], pq[3]);
          }
        }
    });
#pragma unroll
    for (int db = 0; db < 2; ++db)
#pragma unroll
      for (int r = 0; r < 16; ++r) outl[256 * (db * 16 + r)] = w.ga()[(size_t)t * 24 + hq * 3] * O[db][r];
  }
  LDS_FENCE();
  {
    const int qi2 = lane >> 3, sub = lane & 7;
    const float* impq = imp + (wv * 8 + qi2) * 128 + sub * 16;
    float vals[16]; unsigned m16 = 0u;
#pragma unroll
    for (int u = 0; u < 16; ++u) {
      const int j = sub * 16 + u;
      float v = impq[u];
      if (j == 0 || j >= cur - 1) v = -INFINITY;
      vals[u] = v;
      if (j == 0 || j == cur - 1 || j == cur || (cur < 16 && j <= cur)) m16 |= 1u << u;
    }
    if (cur >= 16) {
      for (int round = 0; round < 13; ++round) {
        float bv = vals[0]; int bj = sub * 16;
#pragma unroll
        for (int u = 1; u < 16; ++u) if (vals[u] > bv) { bv = vals[u]; bj = sub * 16 + u; }
        { const float ov = dpp_f<0xB1>(bv); const int oj = dpp_i<0xB1>(bj); if (ov > bv || (ov == bv && oj < bj)) { bv = ov; bj = oj; } }
        { const float ov = dpp_f<0x4E>(bv); const int oj = dpp_i<0x4E>(bj); if (ov > bv || (ov == bv && oj < bj)) { bv = ov; bj = oj; } }
        { const float ov = dpp_f<0x141>(bv); const int oj = dpp_i<0x141>(bj); if (ov > bv || (ov == bv && oj < bj)) { bv = ov; bj = oj; } }
        if (bv > -INFINITY && (bj >> 4) == sub) {
          m16 |= 1u << (bj & 15);
#pragma unroll
          for (int u = 0; u < 16; ++u) if ((bj & 15) == u) vals[u] = -INFINITY;
        }
      }
    }
    selm[(wv * 8 + qi2) * 8 + sub] = (unsigned short)m16;
    unsigned um = m16; um |= __shfl_xor(um, 8); um |= __shfl_xor(um, 16); um |= __shfl_xor(um, 32);
    if (lane < 8) atomicOr(&uni[sub], um);
  }
  __syncthreads();
  if (tid < 128) {
    const int wd = tid >> 4, bt = tid & 15;
    const unsigned uw = uni[wd];
    int pos = __popc(uw & ((1u << bt) - 1u));
    for (int i = 0; i < wd; ++i) pos += __popc(uni[i]);
    if ((uw >> bt) & 1u) tlist[pos] = (unsigned char)tid;
    if (tid == 127) *(int*)(tlist + 128) = pos + ((uw >> bt) & 1u);
  }
  __syncthreads();
  {
    const int nts = *(const int*)(tlist + 128);
    const uint4 mq = *(const uint4*)(selm + (wv * 8 + qi) * 8);
    float m = -INFINITY, l = 0.f;
#pragma unroll
    for (int db = 0; db < 2; ++db)
#pragma unroll
      for (int r = 0; r < 16; ++r) O[db][r] = 0.f;
    tile_loop(Kl, Vl, ksg, vsg, nts, tid, [&](int i) { return (size_t)tlist[nts - 1 - i] * 4096; }, [&](int it) {
      const int j = tlist[nts - 1 - it];
      const unsigned wsel = (j < 32) ? mq.x : (j < 64) ? mq.y : (j < 96) ? mq.z : mq.w;
      const bool sel = (wsel >> (j & 31)) & 1u;
      if (__ballot(sel) == 0ull) return;
      qk_tile(Kl, qf, Sx, lane);
      const float sbh = sel ? slope2 * (float)(64 * j + 4 * h - sq) : -INFINITY;
      if (j == cur) bias_mask<1>(Sx, slope2, ql - 4 * h, 0); else bias_mask<0>(Sx, slope2, 0, 0);
      online_update(Sx, O, m, l, sbh);
      pv_tile(Vl, Sx, O, lane);
    });
    l = xsum32(l);
    const float sc = w.ga()[(size_t)t * 24 + hq * 3 + 1] / fmaxf(l, 1e-30f);
#pragma unroll
    for (int db = 0; db < 2; ++db)
#pragma unroll
      for (int r = 0; r < 16; ++r) outl[256 * (db * 16 + r)] += sc * O[db][r];
  }
  {
    const int j0 = max(0, cur - 8);
    float m = -INFINITY, l = 0.f;
#pragma unroll
    for (int db = 0; db < 2; ++db)
#pragma unroll
      for (int r = 0; r < 16; ++r) O[db][r] = 0.f;
    tile_loop(Kl, Vl, kwg, vwg, cur - j0 + 1, tid, [&](int i) { return (size_t)(cur - i) * 4096; }, [&](int it) {
      const int j = cur - it;
      qk_tile(Kl, qf, Sx, lane);
      const float sbh = slope2 * (float)(64 * j + 4 * h - sq);
      if (j == cur) bias_mask<1>(Sx, slope2, ql - 4 * h, 0);
      else if (j == cur - 8) bias_mask<2>(Sx, slope2, 0, ql - 4 * h);
      else bias_mask<0>(Sx, slope2, 0, 0);
      online_update(Sx, O, m, l, sbh);
      pv_tile(Vl, Sx, O, lane);
    });
    l = xsum32(l);
    const float sc = w.ga()[(size_t)t * 24 + hq * 3 + 2] / fmaxf(l, 1e-30f);
#pragma unroll
    for (int db = 0; db < 2; ++db)
#pragma unroll
      for (int r = 0; r < 16; ++r) O[db][r] = outl[256 * (db * 16 + r)] + sc * O[db][r];
  }
  {
    bf16* op = w.oa() + (size_t)t * 512 + hq * 64;
#pragma unroll
    for (int db = 0; db < 2; ++db)
#pragma unroll
      for (int a = 0; a < 4; ++a) {
        uint2 v; v.x = pk2(O[db][4 * a], O[db][4 * a + 1]); v.y = pk2(O[db][4 * a + 2], O[db][4 * a + 3]);
        *(uint2*)(op + db * 32 + 8 * a + 4 * h) = v;
      }
  }
  __syncthreads();
}

__device__ __forceinline__ void moba_store_part(const WS& w, const f32x16 (&O)[2], float m, float l, int t, int hd, int slot, bool valid, int lane) {
  const int h = lane >> 5;
  l = xsum32(l);
  const float sc = 1.f / fmaxf(l, 1e-30f);
  if (valid) {
    bf16* op = w.mbpart() + ((size_t)(t * 8 + hd) * 4 + slot) * 64;
#pragma unroll
    for (int db = 0; db < 2; ++db)
#pragma unroll
      for (int a = 0; a < 4; ++a) {
        uint2 v; v.x = pk2(sc * O[db][4 * a], sc * O[db][4 * a + 1]); v.y = pk2(sc * O[db][4 * a + 2], sc * O[db][4 * a + 3]);
        *(uint2*)(op + db * 32 + 8 * a + 4 * h) = v;
      }
    if (h == 0) w.mblse()[(size_t)(t * 8 + hd) * 4 + slot] = (l > 0.f) ? m + __builtin_amdgcn_logf(l) : -INFINITY;
  }
}
__device__ __forceinline__ void moba_gate_unit(const WS& w, unsigned char* lds, int unit, int shadow = 0) {
  int tid = threadIdx.x; asm volatile("" : "+v"(tid));
  const int lane = tid & 63, wv = tid >> 6, h = lane >> 5;
  unsigned char* Kl = lds; unsigned char* Vl = lds + KL_BYTES;
  const int bh = unit >> 6, c128 = unit & 63, hd = bh & 7;
  const int s0 = c128 * 128, cur = s0 >> 8;
  const int sq = s0 + wv * 32 + (lane & 31), t = (bh >> 3) * S + sq;
  const bf16* qg = w.qkvb() + (size_t)(0 * 16 + bh) * S * 64;
  bf16x8 qf[4];
#pragma unroll
  for (int ks = 0; ks < 4; ++ks) qf[ks] = *(const bf16x8*)(qg + (size_t)sq * 64 + ks * 16 + 8 * h);
  StageRegs sr;
  sr.k0 = sr.k1 = sr.v0 = sr.v1 = make_uint4(0, 0, 0, 0);
  f32x16 Sx[2];
  const bf16* km = w.kmb() + (size_t)bh * 4096;
  stage_load(km, km, sr, tid);
  __syncthreads(); stage_store(Kl, Vl, sr, tid); __syncthreads();
  qk_tile(Kl, qf, Sx, lane);
  float gv[16];
#pragma unroll
  for (int r = 0; r < 16; ++r) { const int n = (r & 3) + 8 * (r >> 2) + 4 * h; gv[r] = (n < cur) ? Sx[0][r] + Sx[1][r] : -INFINITY; }
  int* lcnt = (int*)(lds + KL_BYTES + VL_BYTES);
  if (tid < 64) lcnt[tid] = 0;
  __syncthreads();
  int pkn[3], pkp[3];
#pragma unroll
  for (int round = 0; round < 3; ++round) {
    float bv = gv[0]; int bn = 4 * h;
#pragma unroll
    for (int r = 1; r < 16; ++r) if (gv[r] > bv) { bv = gv[r]; bn = (r & 3) + 8 * (r >> 2) + 4 * h; }
    { const float ov = __shfl_xor(bv, 32); const int on = __shfl_xor(bn, 32); if (ov > bv || (ov == bv && on < bn)) { bv = ov; bn = on; } }
    const bool has = bv > -INFINITY;
    pkn[round] = has ? bn : -1; pkp[round] = 0;
    if (has) {
#pragma unroll
      for (int r = 0; r < 16; ++r) if (bn == (r & 3) + 8 * (r >> 2) + 4 * h) gv[r] = -INFINITY;
      if (h == 0) pkp[round] = atomicAdd(&lcnt[bn], 1);
    } else if (h == 0) (shadow ? (float*)(w.hid() + 8388608) : w.mblse())[(size_t)(t * 8 + hd) * 4 + round] = -INFINITY;
  }
  __syncthreads();
  if (tid < 32) { const int c = lcnt[tid]; lcnt[32 + tid] = c ? atomicAdd(&w.mbcnt()[shadow * 512 + bh * 32 + tid], c) : 0; }
  __syncthreads();
  if (h == 0) {
#pragma unroll
    for (int round = 0; round < 3; ++round)
      if (pkn[round] >= 0) (shadow ? (unsigned short*)w.hid() : w.mbql())[(size_t)(bh * 32 + pkn[round]) * 8192 + lcnt[32 + pkn[round]] + pkp[round]] = (unsigned short)((sq << 2) | round);
  }
  __syncthreads();
}
__device__ __forceinline__ void moba_own_unit(const WS& w, unsigned char* lds, int unit) {
  int tid = threadIdx.x; asm volatile("" : "+v"(tid));
  const int lane = tid & 63, wv = tid >> 6, h = lane >> 5;
  unsigned char* Kl = lds; unsigned char* Vl = lds + KL_BYTES;
  const int bh = unit >> 6, c128 = unit & 63, hd = bh & 7;
  const int s0 = c128 * 128, cur = s0 >> 8;
  const int sq = s0 + wv * 32 + (lane & 31), t = (bh >> 3) * S + sq;
  const bf16* qg = w.qkvb() + (size_t)(0 * 16 + bh) * S * 64;
  const bf16* kg = w.qkvb() + (size_t)(1 * 16 + bh) * S * 64;
  const bf16* vg = w.qkvb() + (size_t)(2 * 16 + bh) * S * 64;
  const float slope2 = slope_b(hd) * LOG2E;
  bf16x8 qf[4];
#pragma unroll
  for (int ks = 0; ks < 4; ++ks) qf[ks] = *(const bf16x8*)(qg + (size_t)sq * 64 + ks * 16 + 8 * h);
  StageRegs sr;
  sr.k0 = sr.k1 = sr.v0 = sr.v1 = make_uint4(0, 0, 0, 0);
  f32x16 Sx[2], O[2];
  float m = -INFINITY, l = 0.f;
#pragma unroll
  for (int db = 0; db < 2; ++db)
#pragma unroll
    for (int r = 0; r < 16; ++r) O[db][r] = 0.f;
  const int nown = 2 * ((s0 >> 7) & 1) + 2;
  tile_loop(Kl, Vl, kg, vg, nown, tid, [&](int i) { return (size_t)(cur * 256 + (nown - 1 - i) * 64) * 64; }, [&](int it) {
    const int tt = nown - 1 - it;
    const int pos0 = cur * 256 + tt * 64;
    if (pos0 > s0 + wv * 32 + 31) return;
    qk_tile(Kl, qf, Sx, lane);
    bias_mask<1>(Sx, slope2, sq - pos0 - 4 * h, 0);
    online_update(Sx, O, m, l, slope2 * (float)(pos0 + 4 * h - sq));
    pv_tile(Vl, Sx, O, lane);
  });
  moba_store_part(w, O, m, l, t, hd, 3, true, lane);
  __syncthreads();
}
__device__ __forceinline__ void moba_gath_unit(const WS& w, unsigned char* lds, int list, int chunk, int cnt) {
  int tid = threadIdx.x; asm volatile("" : "+v"(tid));
  const int lane = tid & 63, wv = tid >> 6, h = lane >> 5;
  unsigned char* Kl = lds; unsigned char* Vl = lds + KL_BYTES;
  const int bh = list >> 5, n = list & 31, hd = bh & 7;
  const int qidx = chunk * 128 + wv * 32 + (lane & 31);
  const bool valid = qidx < cnt;
  const unsigned ent = w.mbql()[(size_t)list * 8192 + (valid ? qidx : 0)];
  const int sq = (int)(ent >> 2), slot = (int)(ent & 3u), t = (bh >> 3) * S + sq;
  const bf16* qg = w.qkvb() + (size_t)(0 * 16 + bh) * S * 64;
  const bf16* kg = w.qkvb() + ((size_t)(1 * 16 + bh) * S + n * 256) * 64;
  const bf16* vg = w.qkvb() + ((size_t)(2 * 16 + bh) * S + n * 256) * 64;
  const float slope2 = slope_b(hd) * LOG2E;
  bf16x8 qf[4];
#pragma unroll
  for (int ks = 0; ks < 4; ++ks) qf[ks] = *(const bf16x8*)(qg + (size_t)sq * 64 + ks * 16 + 8 * h);
  StageRegs sr;
  sr.k0 = sr.k1 = sr.v0 = sr.v1 = make_uint4(0, 0, 0, 0);
  f32x16 Sx[2], O[2];
  float m = -INFINITY, l = 0.f;
#pragma unroll
  for (int db = 0; db < 2; ++db)
#pragma unroll
    for (int r = 0; r < 16; ++r) O[db][r] = 0.f;
  tile_loop(Kl, Vl, kg, vg, 4, tid, [&](int i) { return (size_t)((3 - i) * 64) * 64; }, [&](int it) {
    const int tt = 3 - it;
    qk_tile(Kl, qf, Sx, lane);
    bias_mask<0>(Sx, slope2, 0, 0);
    online_update(Sx, O, m, l, slope2 * (float)(n * 256 + tt * 64 + 4 * h - sq));
    pv_tile(Vl, Sx, O, lane);
  });
  moba_store_part(w, O, m, l, t, hd, slot, valid, lane);
  __syncthreads();
}

#define XB_TMO      128
#define XB_XCNT(j)  (256  + 64 * (j))
#define XB_XSUB(j)  (1280 + 64 * (j))
#define XB_XGEN(j)  (2304 + 64 * (j))
#define XB_TOP      3328
#define XB_TOPGEN   3392
#define XCD_BAR_WORDS 3456
#define XB_SPIN_CAP (1u << 18)
__device__ __forceinline__ unsigned xb_ld(unsigned* p)              { return __hip_atomic_load(p, __ATOMIC_RELAXED, __HIP_MEMORY_SCOPE_AGENT); }
__device__ __forceinline__ unsigned xb_add(unsigned* p, unsigned v) { return __hip_atomic_fetch_add(p, v, __ATOMIC_RELAXED, __HIP_MEMORY_SCOPE_AGENT); }
__device__ __forceinline__ unsigned xb_xcc_id() { return (unsigned)__builtin_amdgcn_s_getreg((3 << 11) | 20) & 0xFu; }
#define XB_SPIN(cond, bar) do { unsigned _sp = 0; while (cond) { __builtin_amdgcn_s_sleep(1); \
    if ((++_sp & 255u) == 0u) { if (xb_ld(&(bar)[XB_TMO])) break; if (_sp > XB_SPIN_CAP) { atomicAdd(&(bar)[XB_TMO], 1u); break; } } } } while (0)
struct XcdBarrier { unsigned* bar; unsigned x; volatile LAS unsigned* st; };
__device__ __forceinline__ XcdBarrier xcd_barrier_post(unsigned* bar, volatile LAS unsigned* st) {
    XcdBarrier b; b.bar = bar; b.x = xb_xcc_id(); b.st = st;
    if (threadIdx.x == 0) (void)xb_add(&bar[XB_XCNT(b.x)], 1u);
    return b;
}
__device__ __forceinline__ void xcd_barrier_complete(unsigned* bar, unsigned x, unsigned& nloc, unsigned& nx) {
    const unsigned G = gridDim.x * gridDim.y * gridDim.z;
    unsigned sum, cnt, mine, sp = 0u;
    for (;;) {
        sum = 0u; cnt = 0u; mine = 0u;
#pragma unroll
        for (unsigned j = 0; j < 16; ++j) { const unsigned c = xb_ld(&bar[XB_XCNT(j)]); sum += c; cnt += (c > 0u) ? 1u : 0u; mine = (j == x) ? c : mine; }
        if (sum == G) break;
        __builtin_amdgcn_s_sleep(1);
        if ((++sp & 255u) == 0u) { if (xb_ld(&bar[XB_TMO])) break; if (sp > XB_SPIN_CAP) { atomicAdd(&bar[XB_TMO], 1u); break; } }
    }
    nloc = mine > 0u ? mine : 1u; nx = cnt > 0u ? cnt : 1u;
}
__device__ __forceinline__ void xcd_barrier(const XcdBarrier& b) {
    asm volatile("s_waitcnt vmcnt(0)" ::: "memory");
    __syncthreads();
    if (threadIdx.x == 0) {
        unsigned* bar = b.bar;
        __builtin_amdgcn_s_waitcnt(0);
        unsigned nloc = b.st[0], nx = b.st[1];
        if (nloc == 0u) { xcd_barrier_complete(bar, b.x, nloc, nx); b.st[0] = nloc; b.st[1] = nx; }
        const unsigned old = xb_add(&bar[XB_XSUB(b.x)], 1u);
        const unsigned gen = old / nloc;
        if (old + 1u == (gen + 1u) * nloc) {
            __builtin_amdgcn_fence(__ATOMIC_RELEASE, "agent");
            asm volatile("s_waitcnt vmcnt(0)" ::: "memory");
            const unsigned og = xb_add(&bar[XB_TOP], 1u);
            const unsigned tg = og / nx;
            if (og + 1u == (tg + 1u) * nx) xb_add(&bar[XB_TOPGEN], 1u);
            else XB_SPIN(xb_ld(&bar[XB_TOPGEN]) == tg, bar);
            __builtin_amdgcn_fence(__ATOMIC_ACQUIRE, "agent");
            xb_add(&bar[XB_XGEN(b.x)], 1u);
            asm volatile("s_waitcnt vmcnt(0)" ::: "memory");
        } else {
            XB_SPIN(xb_ld(&bar[XB_XGEN(b.x)]) == gen, bar);
            __builtin_amdgcn_fence(__ATOMIC_ACQUIRE, "agent");
            asm volatile("s_waitcnt vmcnt(0)" ::: "memory");
        }
    }
    __syncthreads();
}

__global__ void __launch_bounds__(NT, 2) fwd_megakernel(Params p) {
  cg::grid_group grid = cg::this_grid();
  constexpr int LDS_MAIN = ATT_LDS > GEMM_LDS ? ATT_LDS : GEMM_LDS;
  static_assert(GEMM2_LDS <= 65536 && LDS_MAIN >= 65536 + 1024, "LDS map");
  __shared__ __attribute__((aligned(16))) unsigned char lds_raw[LDS_MAIN + 16];
  float* lds = (float*)lds_raw;
  const WS w = make_ws(p.ws);
  const int bid = blockIdx.x, nblk = gridDim.x;
  volatile LAS unsigned* xst = (volatile LAS unsigned*)(LAS unsigned char*)(lds_raw + LDS_MAIN);
  if (threadIdx.x < 4) xst[threadIdx.x] = 0u;
  __syncthreads();
  const XcdBarrier xb = xcd_barrier_post((unsigned*)(p.ws + O_BAR), xst);
#define IDS() int tid = threadIdx.x; asm volatile("" : "+v"(tid)); const int lane = tid & 63; const int gtid = bid * NT + tid, gthreads = nblk * NT; const int gw = gtid >> 6, ngw = gthreads >> 6; (void)lane; (void)gw; (void)ngw; (void)gthreads;

  if (PHASES & (1u << 0)) for (int rep_ = 0; rep_ <= (int)((REPMASK >> 0) & 1u); ++rep_) {
  IDS();
  {
    for (int i = tid; i < 2048; i += NT) lds[i] = siluf_(p.c[i]);
    __syncthreads();
    for (int cb = bid; cb < 384; cb += nblk) {
      const int c = tid & 15, kg = tid >> 4;
      float a0 = 0.f, a1 = 0.f;
      const float* wp = p.w_ada + (size_t)(64 * kg) * 6144 + cb * 16 + c;
#pragma unroll 16
      for (int k = 0; k < 64; ++k) { const float wv_ = wp[(size_t)k * 6144]; a0 += lds[64 * kg + k] * wv_; a1 += lds[1024 + 64 * kg + k] * wv_; }
      lds[2048 + (kg * 2 + 0) * 16 + c] = a0; lds[2048 + (kg * 2 + 1) * 16 + c] = a1;
      __syncthreads();
      if (tid < 32) {
        const int b = tid >> 4;
        float a = p.b_ada[cb * 16 + c];
        for (int g = 0; g < 16; ++g) a += lds[2048 + (g * 2 + b) * 16 + c];
        w.ada()[b * 6144 + cb * 16 + c] = a;
      }
      __syncthreads();
    }
  }
  {
    auto cvt = [&](const float* src_, bf16* dst_, int n4) {
      for (int idx = gtid; idx < n4; idx += 4 * gthreads) {
        float4 v[4];
#pragma unroll
        for (int u = 0; u < 4; ++u) v[u] = ((const float4*)src_)[min(idx + u * gthreads, n4 - 1)];
#pragma unroll
        for (int u = 0; u < 4; ++u) if (idx + u * gthreads < n4) ((uint2*)dst_)[idx + u * gthreads] = to_bf16x4(v[u]);
      }
    };
    cvt(p.w_in, w.wb_in(), D * INC / 4); cvt(p.w_up_a, w.wb_upa(), 512 * D / 4); cvt(p.w_up_b, w.wb_upb(), 512 * D / 4); cvt(p.w_out, w.wb_out(), D * D / 4);
    cvt(p.w_router, w.wb_rt(), D * 256 / 4); cvt(p.w_s_gate, w.wb_sg(), D * 256 / 4); cvt(p.w_s_up, w.wb_su(), D * 256 / 4); cvt(p.w_s_down, w.wb_sd(), 256 * D / 4);
  }
  for (int idx = gtid; idx < 256; idx += gthreads) w.counts()[idx] = 0;
  for (int idx = gtid; idx < 8; idx += gthreads) w.erb()[512 + idx] = 0;
  for (int idx = gtid; idx < 1024; idx += gthreads) w.mbcnt()[idx] = 0;
  for (int idx = gtid; idx < 8 * 64; idx += gthreads) w.kcb()[((size_t)(idx >> 6) * 512 + 511) * 64 + (idx & 63)] = 0;
  }
  xcd_barrier(xb);
#ifdef EXTRA_SYNCS
  for (int i_ = 0; i_ < EXTRA_SYNCS; ++i_) xcd_barrier(xb);
#endif
  if (PHASES & (1u << 2)) for (int rep_ = 0; rep_ <= (int)((REPMASK >> 2) & 1u); ++rep_) {
  IDS();
  for (int t = gw; t < T; t += ngw) {
    const float* ad = w.ada() + (t >> 13) * 6144;
    rms_mod_row(p.x + (size_t)t * D, p.norm1_g, ad + 1024, ad, w.h1b() + (size_t)t * D, lane);
  }
  }
  xcd_barrier(xb);
  if (PHASES & (1u << 3)) for (int rep_ = 0; rep_ <= (int)((REPMASK >> 3) & 1u); ++rep_) {
  IDS();
  {
    const int tn = (INC + 127) / 128, tm = T / 256;
    const int xg = bid & 7, nl = (tn - xg + 7) >> 3, nlb = (nblk - xg + 7) >> 3;
    for (int it = bid >> 3; it < tm * nl; it += nlb) {
      const int m0 = (it / nl) * 256, n0 = (xg + 8 * (it % nl)) * 128;
      gemm256_tile(lds_raw, m0, n0, T, INC, D,
        [&](int r) { return (const bf16*)(w.h1b() + (size_t)r * D); },
        [&](int k, int c) { return *(const uint2*)(w.wb_in() + (size_t)k * INC + c); },
        [&](int r, int c, float4 v) {
          const int b = r >> 13, s = r & (S - 1);
          if (c < 512) st_bf16x4(w.qa() + (size_t)r * 512 + c, scale4(v, 0.125f * LOG2E));
          else if (c < 1280) { const int cc = c - 512, i = cc >> 7, h = (cc >> 6) & 1, d = cc & 63; st_bf16x4(w.kva() + ((size_t)((i * 2 + b) * 2 + h) * S + s) * 64 + d, v); }
          else if (c < 1304) *(float4*)(w.ga() + (size_t)r * 24 + (c - 1280)) = sig4(v);
          else if (c < 2840) { const int cc = c - 1304, i = cc >> 9, h = (cc >> 6) & 7, d = cc & 63; st_bf16x4(w.qkvb() + ((size_t)((i * 2 + b) * 8 + h) * S + s) * 64 + d, i == 0 ? scale4(v, 0.125f * LOG2E) : v); }
          else st_bf16x4(w.gab() + (size_t)r * 2048 + (c - 2840), sig4(v));
        });
    }
  }
  }
  xcd_barrier(xb);
  if (PHASES & (1u << 4)) for (int rep_ = 0; rep_ <= (int)((REPMASK >> 4) & 1u); ++rep_) {
  IDS();
  {
    for (int item = bid; item < 512; item += nblk) {
      const int ks = item & 7, nt = (item >> 3) & 1, mt = (item >> 4) & 15, which = item >> 8;
      const int m0 = mt * 128, n0 = nt * 128, koff = ks * 256;
      const float* pe = which ? p.pe_v : p.pe_k; const float* w1 = which ? p.w1_v : p.w1_k;
      float* part = w.tmpf() + (size_t)(ks * 2 + which) * 2044 * 256;
      gemm_tile_bf16(lds_raw, m0, n0, 2044, 256, 256,
        [&](int r, int kk) {
          const int k = kk + koff;
          const int bh = r / NC, i = r % NC, b = bh >> 1, h = bh & 1, j = k >> 6, d = k & 63;
          const uint4 u = *(const uint4*)(w.kva() + ((size_t)((which * 2 + b) * 2 + h) * S + 16 * i + j) * 64 + d);
          const float* ep = pe + j * 64 + d;
          const float4 e0 = *(const float4*)ep, e1 = *(const float4*)(ep + 4);
          return pack8(make_float4(__uint_as_float(u.x << 16) + e0.x, __uint_as_float(u.x & 0xffff0000u) + e0.y, __uint_as_float(u.y << 16) + e0.z, __uint_as_float(u.y & 0xffff0000u) + e0.w),
                       make_float4(__uint_as_float(u.z << 16) + e1.x, __uint_as_float(u.z & 0xffff0000u) + e1.y, __uint_as_float(u.w << 16) + e1.z, __uint_as_float(u.w & 0xffff0000u) + e1.w));
        },
        [&](int kk, int c) { return *(const float4*)(w1 + (size_t)(kk + koff) * 256 + c); },
        [&](int r, int c, float4 v) { *(float4*)(part + (size_t)r * 256 + c) = v; });
    }
    for (int item = bid; item < 512; item += nblk) {
      const int bh = item >> 5, n = item & 31, rg = tid >> 3, c8 = tid & 7;
      const bf16* kb = w.qkvb() + ((size_t)(16 + bh) * S + 256 * n) * 64 + c8 * 8;
      float a8[8];
#pragma unroll
      for (int e = 0; e < 8; ++e) a8[e] = 0.f;
#pragma unroll
      for (int i = 0; i < 8; ++i) {
        const uint4 u = *(const uint4*)(kb + (size_t)(rg + 32 * i) * 64);
        a8[0] += __uint_as_float(u.x << 16); a8[1] += __uint_as_float(u.x & 0xffff0000u); a8[2] += __uint_as_float(u.y << 16); a8[3] += __uint_as_float(u.y & 0xffff0000u);
        a8[4] += __uint_as_float(u.z << 16); a8[5] += __uint_as_float(u.z & 0xffff0000u); a8[6] += __uint_as_float(u.w << 16); a8[7] += __uint_as_float(u.w & 0xffff0000u);
      }
      __syncthreads();
#pragma unroll
      for (int e = 0; e < 8; ++e) lds[rg * 64 + c8 * 8 + e] = a8[e];
      __syncthreads();
      if (tid < 64) {
        float s = 0.f;
        for (int r = 0; r < 32; ++r) s += lds[r * 64 + tid];
        const float mean = s * (1.f / 256.f); const bf16 hi = f2bf(mean);
        w.kmb()[((size_t)bh * 64 + n) * 64 + tid] = hi; w.kmb()[((size_t)bh * 64 + 32 + n) * 64 + tid] = f2bf(mean - bf2f(hi));
      }
      __syncthreads();
    }
  }
  }
  xcd_barrier(xb);
  if (PHASES & (1u << 5)) for (int rep_ = 0; rep_ <= (int)((REPMASK >> 5) & 1u); ++rep_) {
  IDS();
  {
    const int tm = 16;
    for (int tile = bid; tile < 2 * tm; tile += nblk) {
      const int which = tile / tm, m0 = (tile % tm) * 128;
      const float* w2 = which ? p.w2_v : p.w2_k;
      gemm_tile_bf16(lds_raw, m0, 0, 2044, 64, 256,
        [&](int r, int k) {
          const float* b1 = which ? p.b1_v : p.b1_k;
          float4 s0 = *(const float4*)(b1 + k), s1 = *(const float4*)(b1 + k + 4);
#pragma unroll
          for (int ks = 0; ks < 8; ++ks) {
            const float* pp = w.tmpf() + ((size_t)(ks * 2 + which) * 2044 + r) * 256 + k;
            const float4 a0 = *(const float4*)pp, a1 = *(const float4*)(pp + 4);
            s0.x += a0.x; s0.y += a0.y; s0.z += a0.z; s0.w += a0.w; s1.x += a1.x; s1.y += a1.y; s1.z += a1.z; s1.w += a1.w;
          }
          return pack8(make_float4(gelu_tanh(s0.x), gelu_tanh(s0.y), gelu_tanh(s0.z), gelu_tanh(s0.w)), make_float4(gelu_tanh(s1.x), gelu_tanh(s1.y), gelu_tanh(s1.z), gelu_tanh(s1.w)));
        },
        [&](int k, int c) { return *(const float4*)(w2 + (size_t)k * 64 + c); },
        [&](int r, int c, float4 v) { const int bh = r / NC, i = r % NC; st_bf16x4(w.kcb() + ((size_t)(which * 4 + bh) * 512 + i) * 64 + c, v); });
    }
    for (int u = (bid + nblk / 2) % nblk; u < 1024; u += nblk) moba_gate_unit(w, lds_raw, u, rep_);
    __syncthreads();
  }
  }
  xcd_barrier(xb);
  if (PHASES & (1u << 6)) for (int rep_ = 0; rep_ <= (int)((REPMASK >> 6) & 1u); ++rep_) {
  IDS();
  {
#ifndef NO_NSA
    for (int u = bid; u < 1024; u += nblk) nsa_unit(w, lds_raw, u);
#endif
    __syncthreads();
#ifndef NO_MOBA
    {
      int* cum = (int*)(lds_raw + 20480);
      __syncthreads();
      for (int i = tid; i < 512; i += NT) cum[1 + i] = (w.mbcnt()[i] + 127) >> 7;
      __syncthreads();
      if (tid < 64) {
        int v[8]; int s = 0;
#pragma unroll
        for (int e = 0; e < 8; ++e) { s += cum[1 + tid * 8 + e]; v[e] = s; }
        int incl = s;
#pragma unroll
        for (int o = 1; o < 64; o <<= 1) { const int y = __shfl_up(incl, o); if (tid >= o) incl += y; }
        const int excl = incl - s;
#pragma unroll
        for (int e = 0; e < 8; ++e) cum[1 + tid * 8 + e] = excl + v[e];
        if (tid == 0) cum[0] = 0;
      }
      __syncthreads();
      const int ngath = cum[512];
      for (int u = bid; u < ngath + 1024; u += nblk) {
        if (u < ngath) {
          int lo = 0, hi = 512;
          while (hi - lo > 1) { const int mid = (lo + hi) >> 1; if (cum[mid] <= u) lo = mid; else hi = mid; }
          moba_gath_unit(w, lds_raw, lo, u - cum[lo], w.mbcnt()[lo]);
        } else moba_own_unit(w, lds_raw, u - ngath);
      }
    }
#endif
    __syncthreads();
  }
  }
  xcd_barrier(xb);
  if (PHASES & (1u << 7)) for (int rep_ = 0; rep_ <= (int)((REPMASK >> 7) & 1u); ++rep_) {
  IDS();
  {
    for (int it = bid >> 3; it < 64; it += (nblk - (bid & 7) + 7) >> 3) {
      const int m0 = ((bid & 7) + 8 * (it >> 3)) * 256, n0 = (it & 7) * 128;
      gemm256_tile_pre(lds_raw, m0, n0, T, D, 512,
        [&](int r) { return (const bf16*)(w.oa() + (size_t)r * 512); },
        [&](int k, int c) { return *(const uint2*)(w.wb_upa() + (size_t)k * D + c); },
        [&](int r, int c) { const uint2 g = *(const uint2*)(w.gab() + (size_t)r * 2048 + c); return make_uint4(g.x, g.y, 0u, 0u); },
        [&](int r, int c, float4 v, uint4 pv) { st_bf16x4((bf16*)w.tmpf() + (size_t)r * D + c, mul4(v, up_bf16x4(pv.x, pv.y))); });
    }
    for (int t = gw; t < T; t += ngw) {
      const int hd = lane >> 3, d8 = lane & 7;
      const float4 ls = *(const float4*)(w.mblse() + (size_t)(t * 8 + hd) * 4);
      const float mx = fmaxf(fmaxf(ls.x, ls.y), fmaxf(ls.z, ls.w));
      const float wgt[4] = {__builtin_amdgcn_exp2f(ls.x - mx), __builtin_amdgcn_exp2f(ls.y - mx), __builtin_amdgcn_exp2f(ls.z - mx), __builtin_amdgcn_exp2f(ls.w - mx)};
      const float inv = 1.f / (wgt[0] + wgt[1] + wgt[2] + wgt[3]);
      float a8[8];
#pragma unroll
      for (int e = 0; e < 8; ++e) a8[e] = 0.f;
      const bf16* pp = w.mbpart() + ((size_t)(t * 8 + hd) * 4) * 64 + d8 * 8;
#pragma unroll
      for (int i = 0; i < 4; ++i) {
        const uint4 u = *(const uint4*)(pp + i * 64);
        const float wi = wgt[i] * inv;
        if (wgt[i] > 0.f) {
          a8[0] += wi * __uint_as_float(u.x << 16); a8[1] += wi * __uint_as_float(u.x & 0xffff0000u); a8[2] += wi * __uint_as_float(u.y << 16); a8[3] += wi * __uint_as_float(u.y & 0xffff0000u);
          a8[4] += wi * __uint_as_float(u.z << 16); a8[5] += wi * __uint_as_float(u.z & 0xffff0000u); a8[6] += wi * __uint_as_float(u.w << 16); a8[7] += wi * __uint_as_float(u.w & 0xffff0000u);
        }
      }
      uint4 o; o.x = pk2(a8[0], a8[1]); o.y = pk2(a8[2], a8[3]); o.z = pk2(a8[4], a8[5]); o.w = pk2(a8[6], a8[7]);
      *(uint4*)(w.ob() + (size_t)t * 512 + hd * 64 + d8 * 8) = o;
    }
    xcd_barrier(xb);
    for (int it = bid >> 3; it < 64; it += (nblk - (bid & 7) + 7) >> 3) {
      const int m0 = ((bid & 7) + 8 * (it >> 3)) * 256, n0 = (it & 7) * 128;
      gemm256_tile_pre(lds_raw, m0, n0, T, D, 512,
        [&](int r) { return (const bf16*)(w.ob() + (size_t)r * 512); },
        [&](int k, int c) { return *(const uint2*)(w.wb_upb() + (size_t)k * D + c); },
        [&](int r, int c) { const uint2 t2 = *(const uint2*)((const bf16*)w.tmpf() + (size_t)r * D + c), g2 = *(const uint2*)(w.gab() + (size_t)r * 2048 + 1024 + c); return make_uint4(t2.x, t2.y, g2.x, g2.y); },
        [&](int r, int c, float4 v, uint4 pv) { const float4 t4 = up_bf16x4(pv.x, pv.y), g4 = up_bf16x4(pv.z, pv.w);
          st_bf16x4(w.mrg() + (size_t)r * D + c, make_float4(t4.x + g4.x * v.x, t4.y + g4.y * v.y, t4.z + g4.z * v.z, t4.w + g4.w * v.w)); });
    }
  }
  }
  xcd_barrier(xb);
  if (PHASES & (1u << 8)) for (int rep_ = 0; rep_ <= (int)((REPMASK >> 8) & 1u); ++rep_) {
  IDS();
  {
    for (int it = bid >> 3; it < 64; it += (nblk - (bid & 7) + 7) >> 3) {
      const int m0 = ((bid & 7) + 8 * (it >> 3)) * 256, n0 = (it & 7) * 128;
      gemm256_tile_pre(lds_raw, m0, n0, T, D, D,
        [&](int r) { return (const bf16*)(w.mrg() + (size_t)r * D); },
        [&](int k, int c) { return *(const uint2*)(w.wb_out() + (size_t)k * D + c); },
        [&](int r, int c) { return *(const uint4*)(p.x + (size_t)r * D + c); },
        [&](int r, int c, float4 v, uint4 pv) { const float4 x4 = make_float4(__uint_as_float(pv.x), __uint_as_float(pv.y), __uint_as_float(pv.z), __uint_as_float(pv.w)), g4 = *(const float4*)(w.ada() + (r >> 13) * 6144 + 2048 + c);
          st_bf16x4((bf16*)w.x1() + (size_t)r * D + c, make_float4(x4.x + g4.x * v.x, x4.y + g4.y * v.y, x4.z + g4.z * v.z, x4.w + g4.w * v.w)); });
    }
  }
  }
  xcd_barrier(xb);
  if (PHASES & (1u << 9)) for (int rep_ = 0; rep_ <= (int)((REPMASK >> 9) & 1u); ++rep_) {
  IDS();
  for (int t = gw; t < T; t += ngw) {
    const float* ad = w.ada() + (t >> 13) * 6144;
    rms_mod_row_b((const bf16*)w.x1() + (size_t)t * D, p.norm2_g, ad + 4096, ad + 3072, w.h1b() + (size_t)t * D, lane);
  }
  }
  xcd_barrier(xb);
  if (PHASES & (1u << 10)) for (int rep_ = 0; rep_ <= (int)((REPMASK >> 10) & 1u); ++rep_) {
  IDS();
  {
    for (int it = bid >> 3; it < 48; it += (nblk - (bid & 7) + 7) >> 3) {
      const int pm = (bid & 7) + 8 * (it / 6), sub = it % 6;
      if (sub < 2) {
        const int m0 = pm * 256, n0 = sub * 128;
        gemm256_tile(lds_raw, m0, n0, T, 256, D,
          [&](int r) { return (const bf16*)(w.h1b() + (size_t)r * D); },
          [&](int k, int c) { return *(const uint2*)(w.wb_rt() + (size_t)k * 256 + c); },
          [&](int r, int c, float4 v) { *(float4*)(w.logits() + (size_t)r * 256 + c) = v; });
      } else {
        const int m0 = pm * 256, h0 = (sub - 2) * 64;
        f32x16 acc[4][2];
        gemm256_core_pf2(lds_raw, acc, m0, 0, T, 128, D,
          [&](int r) { return (const bf16*)(w.h1b() + (size_t)r * D); },
          [&](int k, int c) { const bf16* wp = ((c >> 5) & 1) ? w.wb_su() : w.wb_sg(); return *(const uint2*)(wp + (size_t)k * 256 + h0 + (c >> 6) * 32 + (c & 31)); });
        epi256_pair_rows(acc, lds_raw, m0, h0, T, [&](int r, int hc, float4 g, float4 u) { st_bf16x4(w.shid() + (size_t)r * 256 + hc, make_float4(siluf_(g.x) * u.x, siluf_(g.y) * u.y, siluf_(g.z) * u.z, siluf_(g.w) * u.w)); });
      }
    }
  }
  }
  xcd_barrier(xb);
  if (PHASES & (1u << 11)) for (int rep_ = 0; rep_ <= (int)((REPMASK >> 11) & 1u); ++rep_) {
  IDS();
  {
    float4 lgn = *(const float4*)(w.logits() + (size_t)min(gw, T - 1) * 256 + 4 * lane);
    if (rep_ == 0) for (int t = gw; t < T; t += ngw) {
      const float4 lg = lgn;
      lgn = *(const float4*)(w.logits() + (size_t)min(t + ngw, T - 1) * 256 + 4 * lane);
      const float4 bi = *(const float4*)(p.router_bias + 4 * lane);
      float sv[4] = {sigmoidf_(lg.x), sigmoidf_(lg.y), sigmoidf_(lg.z), sigmoidf_(lg.w)};
      float sb[4] = {sv[0] + bi.x, sv[1] + bi.y, sv[2] + bi.z, sv[3] + bi.w};
      float m1 = -INFINITY, m2 = -INFINITY;
#pragma unroll
      for (int r = 0; r < 4; ++r) { if (sb[r] > m1) { m2 = m1; m1 = sb[r]; } else if (sb[r] > m2) m2 = sb[r]; }
#define TOP2_MERGE(C) { const float o1 = dpp_f<C>(m1), o2 = dpp_f<C>(m2); const float n1 = fmaxf(m1, o1), n2 = fmaxf(fminf(m1, o1), fmaxf(m2, o2)); m1 = n1; m2 = n2; }
      TOP2_MERGE(0xB1) TOP2_MERGE(0x4E) TOP2_MERGE(0x141)
#undef TOP2_MERGE
      const float gs = m1 + m2;
      unsigned gsel = 0;
#pragma unroll
      for (int it = 0; it < 4; ++it) {
        float bv = ((gsel >> (lane >> 3)) & 1u) ? -INFINITY : gs; int bi_ = lane >> 3;
        wave_argmax(bv, bi_);
        gsel |= 1u << bi_;
      }
      const bool gok = (gsel >> (lane >> 3)) & 1u;
      float cnd[4];
#pragma unroll
      for (int r = 0; r < 4; ++r) cnd[r] = gok ? sb[r] : -INFINITY;
      float my_s = 0.f; int my_e = 0; float ssum = 0.f;
#pragma unroll
      for (int it = 0; it < 8; ++it) {
        float bv = cnd[0]; int be = 4 * lane; float bs = sv[0];
#pragma unroll
        for (int r = 1; r < 4; ++r) if (cnd[r] > bv) { bv = cnd[r]; be = 4 * lane + r; bs = sv[r]; }
        wave_argmax3(bv, be, bs);
#pragma unroll
        for (int r = 0; r < 4; ++r) if (be == 4 * lane + r) cnd[r] = -INFINITY;
        ssum += bs;
        if (lane == it) { my_s = bs; my_e = be; }
      }
      if (lane < 8) {
        w.eidx()[t * 8 + lane] = my_e; w.wts()[t * 8 + lane] = my_s / ssum * 2.5f;
        w.etok()[(size_t)my_e * T + atomicAdd(&w.counts()[my_e], 1)] = t * 8 + lane;
      }
    }
    for (int it = bid >> 3; it < 64; it += (nblk - (bid & 7) + 7) >> 3) {
      const int m0 = ((bid & 7) + 8 * (it >> 3)) * 256, n0 = (it & 7) * 128;
      gemm256_tile(lds_raw, m0, n0, T, D, 256,
        [&](int r) { return (const bf16*)(w.shid() + (size_t)r * 256); },
        [&](int k, int c) { return *(const uint2*)(w.wb_sd() + (size_t)k * D + c); },
        [&](int r, int c, float4 v) { st_bf16x4((bf16*)w.y() + (size_t)r * D + c, v); });
    }
  }
  }
  xcd_barrier(xb);
#define EXPERT_LAYOUT() { int* sci = (int*)lds_raw; __syncthreads(); \
    const int cnt_ = w.counts()[tid]; const int pad_ = (cnt_ + 127) >> 7; sci[tid] = pad_; __syncthreads(); \
    int ps_ = 0; for (int e_ = 0; e_ < tid; ++e_) ps_ += sci[e_]; \
    if ((tid & 7) == xg) { xe[3 * (tid >> 3)] = ps_; xe[3 * (tid >> 3) + 1] = pad_; xe[3 * (tid >> 3) + 2] = cnt_; } \
    __syncthreads(); \
    if (tid == 0) { int s = 0; for (int i = 0; i < 32; ++i) { cum[i] = s; s += (xe[3 * i + 1] + 1) >> 1; } cum[32] = s; } \
    __syncthreads(); }
  if (PHASES & (1u << 13)) for (int rep_ = 0; rep_ <= (int)((REPMASK >> 13) & 1u); ++rep_) {
  IDS();
  {
    int* cum = (int*)(lds_raw + 65536);
    int* xe = cum + 64;
    const int xg = bid & 7, nlb = (nblk - xg + 7) >> 3;
    EXPERT_LAYOUT();
    const int ntile = cum[32] * 4;
    for (int t = bid >> 3; t < ntile; t += nlb) {
      int i = 0;
      while (i < 31 && 4 * cum[i + 1] <= t) ++i;
      const int e = xg + 8 * i, nte = cum[i + 1] - cum[i], loc = t - 4 * cum[i];
      const int h0 = (loc / nte) * 64, m0 = (xe[3 * i] + 2 * (loc % nte)) * 128, mend = (xe[3 * i] + xe[3 * i + 1]) * 128;
      const int pst = xe[3 * i] * 128, ecnt = xe[3 * i + 2];
      const int* etk = w.etok() + (size_t)e * T;
      auto rtok = [&](int r) { const int lr = r - pst; const int v = etk[min(lr, T - 1)]; return lr < ecnt ? v : -1; };
      const float* wg = p.w_e_gate + (size_t)e * D * 256; const float* wu = p.w_e_up + (size_t)e * D * 256;
      auto bl = [&](int k, int c) { const float* wp = ((c >> 5) & 1) ? wu : wg; return *(const float4*)(wp + (size_t)k * 256 + h0 + (c >> 6) * 32 + (c & 31)); };
      auto ep = [&](int r, int hc, float4 g, float4 u) { st_bf16x4(w.hid() + (size_t)r * 256 + hc, make_float4(siluf_(g.x) * u.x, siluf_(g.y) * u.y, siluf_(g.z) * u.z, siluf_(g.w) * u.w)); };
      if (m0 + 128 >= mend) {
        f32x16 acc[2][2];
        gemm_core(lds_raw, acc, m0, 0, mend, 128, D,
          [&](int r, int k) { const int pr = rtok(r); return *(const uint4*)(w.h1b() + (size_t)(pr >= 0 ? (pr >> 3) : 0) * D + k); }, bl);
        epi_pair_rows(acc, lds_raw, m0, h0, mend, ep);
      } else {
        f32x16 acc[4][2];
        gemm256_core_pf2(lds_raw, acc, m0, 0, mend, 128, D,
          [&](int r) { const int pr = rtok(r); return (const bf16*)(w.h1b() + (size_t)(pr >= 0 ? (pr >> 3) : 0) * D); }, bl);
        epi256_pair_rows(acc, lds_raw, m0, h0, mend, ep);
      }
    }
  }
  }
  xcd_barrier(xb);
  if (PHASES & (1u << 14)) for (int rep_ = 0; rep_ <= (int)((REPMASK >> 14) & 1u); ++rep_) {
  IDS();
  {
    int* cum = (int*)(lds_raw + 65536);
    int* xe = cum + 64;
    const int xg = bid & 7, nlb = (nblk - xg + 7) >> 3;
    EXPERT_LAYOUT();
    const int ntile = cum[32] * 8;
    for (int t = bid >> 3; t < ntile; t += nlb) {
      int i = 0;
      while (i < 31 && 8 * cum[i + 1] <= t) ++i;
      const int e = xg + 8 * i, nte = cum[i + 1] - cum[i], loc = t - 8 * cum[i];
      const int n0 = (loc / nte) * 128, m0 = (xe[3 * i] + 2 * (loc % nte)) * 128, mend = (xe[3 * i] + xe[3 * i + 1]) * 128;
      const int pst = xe[3 * i] * 128, ecnt = xe[3 * i + 2];
      const int* etk = w.etok() + (size_t)e * T;
      auto rtok = [&](int r) { const int lr = r - pst; const int v = etk[min(lr, T - 1)]; return lr < ecnt ? v : -1; };
      const float* wd = p.w_e_down + (size_t)e * 256 * D;
      auto bl = [&](int k, int c) { return *(const float4*)(wd + (size_t)k * D + c); };
      auto ep = [&](int r, int c, float4 v) { const int pr = rtok(r); if (pr >= 0) st_bf16x4(w.ye() + (size_t)pr * D + c, v); };
      if (m0 + 128 >= mend) gemm_tile_bf16(lds_raw, m0, n0, mend, D, 256, [&](int r, int k) { return *(const uint4*)(w.hid() + (size_t)r * 256 + k); }, bl, ep);
      else gemm256_tile_pre_pf2(lds_raw, m0, n0, mend, D, 256, [&](int r) { return (const bf16*)(w.hid() + (size_t)r * 256); }, bl,
        [&](int r, int) { return make_uint4((unsigned)rtok(r), 0u, 0u, 0u); },
        [&](int r, int c, float4 v, uint4 pv) { const int pr = (int)pv.x; if (pr >= 0) st_bf16x4(w.ye() + (size_t)pr * D + c, v); });
    }
  }
  }
  xcd_barrier(xb);
  if (PHASES & (1u << 15)) for (int rep_ = 0; rep_ <= (int)((REPMASK >> 15) & 1u); ++rep_) {
  IDS();
  for (int t = gw; t < T; t += ngw) {
    const float* g2 = w.ada() + (t >> 13) * 6144 + 5120;
    float4 v[4]; float s = 0.f;
#pragma unroll
    for (int j = 0; j < 4; ++j) {
      const float4 a = bf4_to_f4(((const uint2*)((const bf16*)w.x1() + (size_t)t * D))[lane + 64 * j]), gg = ((const float4*)g2)[lane + 64 * j];
      float4 yy = bf4_to_f4(((const uint2*)((const bf16*)w.y() + (size_t)t * D))[lane + 64 * j]);
#pragma unroll
      for (int k = 0; k < 8; ++k) {
        const float wk = w.wts()[t * 8 + k];
        const uint2 e = ((const uint2*)(w.ye() + (size_t)(t * 8 + k) * D))[lane + 64 * j];
        yy.x += wk * __uint_as_float(e.x << 16); yy.y += wk * __uint_as_float(e.x & 0xffff0000u); yy.z += wk * __uint_as_float(e.y << 16); yy.w += wk * __uint_as_float(e.y & 0xffff0000u);
      }
      v[j].x = a.x + gg.x * yy.x; v[j].y = a.y + gg.y * yy.y; v[j].z = a.z + gg.z * yy.z; v[j].w = a.w + gg.w * yy.w;
      s += v[j].x * v[j].x + v[j].y * v[j].y + v[j].z * v[j].z + v[j].w * v[j].w;
    }
    s = wave_sum(s);
    const float rs = rsqrtf(s * (1.f / D) + 1e-6f);
#pragma unroll
    for (int j = 0; j < 4; ++j) {
      const float4 gg = ((const float4*)p.final_g)[lane + 64 * j];
      float4 o; o.x = v[j].x * rs * gg.x; o.y = v[j].y * rs * gg.y; o.z = v[j].z * rs * gg.z; o.w = v[j].w * rs * gg.w;
      ((float4*)(p.out + (size_t)t * D))[lane + 64 * j] = o;
    }
  }
  }
}

extern "C" void kernel_launch(void* const* d_in, const int* in_sizes, int n_in, void* d_out, int out_size, void* d_ws, size_t ws_size, hipStream_t stream) {
  static int grid_blocks = 0;
  if (!grid_blocks) {
    int dev = 0, cus = 0, per_cu = 0;
    (void)hipGetDevice(&dev);
    (void)hipDeviceGetAttribute(&cus, hipDeviceAttributeMultiprocessorCount, dev);
    (void)hipOccupancyMaxActiveBlocksPerMultiprocessor(&per_cu, fwd_megakernel, NT, 0);
    if (per_cu > 2) per_cu = 2;
    if (per_cu < 1) per_cu = 1;
    grid_blocks = cus * per_cu;
    if (n_in != 27 || ws_size < O_END) { fprintf(stderr, "kernel_launch: bad n_in %d or ws %zu < %zu\n", n_in, ws_size, (size_t)O_END); grid_blocks = -1; }
  }
  if (grid_blocks < 0) return;
  Params p{};
  const float** pp = (const float**)&p;
  for (int i = 0; i < 27; ++i) pp[i] = (const float*)d_in[i];
  p.out = (float*)d_out; p.ws = (unsigned char*)d_ws;
  (void)hipMemsetAsync((char*)d_ws + O_BAR, 0, XCD_BAR_WORDS_C * 4, stream);
  void* args[] = {&p};
  hipError_t e = hipLaunchCooperativeKernel((void*)fwd_megakernel, dim3(grid_blocks), dim3(NT), args, 0, stream);
  if (e != hipSuccess) fprintf(stderr, "cooperative launch failed: %s (grid %d)\n", hipGetErrorString(e), grid_blocks);
}
```

```cpp
#include <hip/hip_runtime.h>
#include <hip/hip_cooperative_groups.h>
#include <cstdio>
#include <cstdint>
namespace cg = cooperative_groups;

typedef float f32x16 __attribute__((ext_vector_type(16)));
typedef short bf16x8 __attribute__((ext_vector_type(8)));
typedef short v4i16_t __attribute__((ext_vector_type(4)));
typedef __bf16 bf16x2_t __attribute__((ext_vector_type(2)));
typedef float f32x2_t __attribute__((ext_vector_type(2)));
typedef unsigned short bf16;
#define LAS __attribute__((address_space(3)))
__device__ __forceinline__ unsigned pk2(float a, float b) { f32x2_t v = {a, b}; bf16x2_t r = __builtin_convertvector(v, bf16x2_t); return __builtin_bit_cast(unsigned, r); }
__device__ __forceinline__ bf16 f2bf(float a) { return (bf16)(pk2(a, 0.f) & 0xffffu); }
__device__ __forceinline__ float bf2f(bf16 u) { return __uint_as_float((unsigned)u << 16); }
__device__ __forceinline__ uint4 pack8(float4 a, float4 b) { uint4 r; r.x = pk2(a.x, a.y); r.y = pk2(a.z, a.w); r.z = pk2(b.x, b.y); r.w = pk2(b.z, b.w); return r; }

#ifndef PHASES
#define PHASES 0xffffu
#endif
#ifndef REPMASK
#define REPMASK 0u
#endif
constexpr int NT = 256;
constexpr int T = 16384, S = 8192, D = 1024, INC = 4888;
constexpr int NC = 511;
constexpr int NSLOT = 131072 + 256 * 128;

struct Params {
  const float *x, *c, *w_ada, *b_ada, *norm1_g, *w_in, *pe_k, *w1_k, *b1_k, *w2_k, *pe_v, *w1_v, *b1_v, *w2_v;
  const float *w_up_a, *w_up_b, *w_out, *norm2_g, *w_router, *router_bias, *w_e_gate, *w_e_up, *w_e_down;
  const float *w_s_gate, *w_s_up, *w_s_down, *final_g;
  float* out; unsigned char* ws;
};

constexpr size_t al(size_t x) { return (x + 255) & ~(size_t)255; }
constexpr int XCD_BAR_WORDS_C = 3456;
constexpr size_t O_ADAP = 0;
constexpr size_t O_ADA = O_ADAP + al(32 * 2 * 6144 * 4);
constexpr size_t O_CNT = O_ADA + al(2 * 6144 * 4);
constexpr size_t O_NRB = O_CNT + al(256 * 4);
constexpr size_t O_BLKE = O_NRB + al(256);
constexpr size_t O_ERB = O_BLKE + al(2048 * 4);
constexpr size_t O_BAR = O_ERB + al(1024 * 4);
constexpr size_t O_TMPF = O_BAR + al(XCD_BAR_WORDS_C * 4);
constexpr size_t O_H1B = O_TMPF + al((size_t)T * D * 4);
constexpr size_t O_MRG = O_H1B + al((size_t)T * D * 2);
constexpr size_t O_QA = O_MRG + al((size_t)T * D * 2);
constexpr size_t O_KVA = O_QA + al((size_t)T * 512 * 2);
constexpr size_t O_GA = O_KVA + al((size_t)6 * T * 128 * 2);
constexpr size_t O_QKVB = O_GA + al((size_t)T * 24 * 4);
constexpr size_t O_GAB = O_QKVB + al((size_t)3 * T * 512 * 2);
constexpr size_t O_HIDC = O_GAB + al((size_t)T * 2048 * 2);
constexpr size_t O_KC = O_HIDC + al((size_t)2 * 2044 * 256 * 2);
constexpr size_t O_KMEAN = O_KC + al((size_t)2 * 4 * 512 * 64 * 2);
constexpr size_t O_OA = O_KMEAN + al((size_t)16 * 64 * 64 * 2);
constexpr size_t O_OB = O_OA + al((size_t)T * 512 * 2);
constexpr size_t O_X1 = O_OB + al((size_t)T * 512 * 2);
constexpr size_t O_LOG = O_X1 + al((size_t)T * D * 4);
constexpr size_t O_Y = O_LOG + al((size_t)T * 256 * 4);
constexpr size_t O_SHID = O_Y + al((size_t)T * D * 4);
constexpr size_t O_EIDX = O_SHID + al((size_t)T * 256 * 2);
constexpr size_t O_WTS = O_EIDX + al((size_t)T * 8 * 4);
constexpr size_t O_POS = O_WTS + al((size_t)T * 8 * 4);
constexpr size_t O_RTOK = O_POS + al((size_t)T * 8 * 4);
constexpr size_t O_RW = O_RTOK + al((size_t)NSLOT * 4);
constexpr size_t O_HID = O_RW + al((size_t)NSLOT * 4);
constexpr size_t O_YE = O_HID + al((size_t)NSLOT * 256 * 2);
constexpr size_t O_WIN = O_YE + al((size_t)T * 8 * D * 2);
constexpr size_t O_WUPA = O_WIN + al((size_t)D * INC * 2);
constexpr size_t O_WUPB = O_WUPA + al((size_t)512 * D * 2);
constexpr size_t O_WOUT = O_WUPB + al((size_t)512 * D * 2);
constexpr size_t O_WRT = O_WOUT + al((size_t)D * D * 2);
constexpr size_t O_WSG = O_WRT + al((size_t)D * 256 * 2);
constexpr size_t O_WSU = O_WSG + al((size_t)D * 256 * 2);
constexpr size_t O_WSD = O_WSU + al((size_t)D * 256 * 2);
constexpr size_t O_MBCNT = O_WSD + al((size_t)256 * D * 2);
constexpr size_t O_MBQL = O_MBCNT + al(1024 * 4);
constexpr size_t O_MBLSE = O_MBQL + al((size_t)512 * 8192 * 2);
constexpr size_t O_W2F = O_MBLSE + al((size_t)T * 8 * 4 * 4);
constexpr size_t O_C2 = O_W2F + al((size_t)6 * 1024 * 256 * 2);
constexpr size_t O_SQP = O_C2 + al((size_t)2 * 768 * 4);
constexpr size_t O_END = O_SQP + al((size_t)T * 16 * 4);
constexpr size_t O_MBPART = O_YE;
static_assert(O_END <= ((size_t)1 << 30), "workspace map exceeds 1 GiB");

struct WS {
  unsigned char* base;
  __device__ __forceinline__ float* adap() const { return (float*)(base + O_ADAP); }
  __device__ __forceinline__ float* ada() const { return (float*)(base + O_ADA); }
  __device__ __forceinline__ float* tmpf() const { return (float*)(base + O_TMPF); }
  __device__ __forceinline__ float* ga() const { return (float*)(base + O_GA); }
  __device__ __forceinline__ bf16* gab() const { return (bf16*)(base + O_GAB); }
  __device__ __forceinline__ float* x1() const { return (float*)(base + O_X1); }
  __device__ __forceinline__ float* logits() const { return (float*)(base + O_LOG); }
  __device__ __forceinline__ float* y() const { return (float*)(base + O_Y); }
  __device__ __forceinline__ float* wts() const { return (float*)(base + O_WTS); }
  __device__ __forceinline__ float* row_w() const { return (float*)(base + O_RW); }
  __device__ __forceinline__ bf16* h1b() const { return (bf16*)(base + O_H1B); }
  __device__ __forceinline__ bf16* mrg() const { return (bf16*)(base + O_MRG); }
  __device__ __forceinline__ bf16* hidc() const { return (bf16*)(base + O_HIDC); }
  __device__ __forceinline__ bf16* oa() const { return (bf16*)(base + O_OA); }
  __device__ __forceinline__ bf16* ob() const { return (bf16*)(base + O_OB); }
  __device__ __forceinline__ bf16* shid() const { return (bf16*)(base + O_SHID); }
  __device__ __forceinline__ bf16* hid() const { return (bf16*)(base + O_HID); }
  __device__ __forceinline__ bf16* ye() const { return (bf16*)(base + O_YE); }
  __device__ __forceinline__ bf16* w2f() const { return (bf16*)(base + O_W2F); }
  __device__ __forceinline__ float* c2() const { return (float*)(base + O_C2); }
  __device__ __forceinline__ float* sqp() const { return (float*)(base + O_SQP); }
  __device__ __forceinline__ bf16* mbpart() const { return (bf16*)(base + O_MBPART); }
  __device__ __forceinline__ int* mbcnt() const { return (int*)(base + O_MBCNT); }
  __device__ __forceinline__ unsigned short* mbql() const { return (unsigned short*)(base + O_MBQL); }
  __device__ __forceinline__ float* mblse() const { return (float*)(base + O_MBLSE); }
  __device__ __forceinline__ bf16* wb_in() const { return (bf16*)(base + O_WIN); }
  __device__ __forceinline__ bf16* wb_upa() const { return (bf16*)(base + O_WUPA); }
  __device__ __forceinline__ bf16* wb_upb() const { return (bf16*)(base + O_WUPB); }
  __device__ __forceinline__ bf16* wb_out() const { return (bf16*)(base + O_WOUT); }
  __device__ __forceinline__ bf16* wb_rt() const { return (bf16*)(base + O_WRT); }
  __device__ __forceinline__ bf16* wb_sg() const { return (bf16*)(base + O_WSG); }
  __device__ __forceinline__ bf16* wb_su() const { return (bf16*)(base + O_WSU); }
  __device__ __forceinline__ bf16* wb_sd() const { return (bf16*)(base + O_WSD); }
  __device__ __forceinline__ bf16* qa() const { return (bf16*)(base + O_QA); }
  __device__ __forceinline__ bf16* kva() const { return (bf16*)(base + O_KVA); }
  __device__ __forceinline__ bf16* qkvb() const { return (bf16*)(base + O_QKVB); }
  __device__ __forceinline__ int* etok() const { return (int*)(base + O_QKVB); }
  __device__ __forceinline__ bf16* kcb() const { return (bf16*)(base + O_KC); }
  __device__ __forceinline__ bf16* kmb() const { return (bf16*)(base + O_KMEAN); }
  __device__ __forceinline__ int* counts() const { return (int*)(base + O_CNT); }
  __device__ __forceinline__ int* nrb() const { return (int*)(base + O_NRB); }
  __device__ __forceinline__ int* blk_e() const { return (int*)(base + O_BLKE); }
  __device__ __forceinline__ int* erb() const { return (int*)(base + O_ERB); }
  __device__ __forceinline__ int* eidx() const { return (int*)(base + O_EIDX); }
  __device__ __forceinline__ int* pos() const { return (int*)(base + O_POS); }
  __device__ __forceinline__ int* row_tok() const { return (int*)(base + O_RTOK); }
};
__device__ __forceinline__ WS make_ws(unsigned char* b) { WS w; w.base = b; return w; }

__device__ __forceinline__ float sigmoidf_(float v) { return __builtin_amdgcn_rcpf(1.f + __builtin_amdgcn_exp2f(-1.4426950408889634f * v)); }
__device__ __forceinline__ float siluf_(float v) { return v * __builtin_amdgcn_rcpf(1.f + __builtin_amdgcn_exp2f(-1.4426950408889634f * v)); }
__device__ __forceinline__ float gelu_tanh(float v) { const float u = 0.7978845608028654f * (v + 0.044715f * v * v * v); return v * (1.f - __builtin_amdgcn_rcpf(1.f + __builtin_amdgcn_exp2f(2.f * 1.4426950408889634f * u))); }
__device__ __forceinline__ float slope_a(int hq) { return 0.70710678118654752f * __uint_as_float((unsigned)(127 - hq) << 23); }
__device__ __forceinline__ float slope_b(int h) { return __uint_as_float((unsigned)(126 - h) << 23); }
template <int CTRL> __device__ __forceinline__ int dpp_i(int v) { return __builtin_amdgcn_update_dpp(0, v, CTRL, 0xf, 0xf, true); }
template <int CTRL> __device__ __forceinline__ float dpp_f(float v) { return __builtin_bit_cast(float, __builtin_amdgcn_update_dpp(0, __builtin_bit_cast(int, v), CTRL, 0xf, 0xf, true)); }
__device__ __forceinline__ void swap16_f(float v, float& a, float& b) { const auto r = __builtin_amdgcn_permlane16_swap(__builtin_bit_cast(unsigned, v), __builtin_bit_cast(unsigned, v), false, false); a = __builtin_bit_cast(float, r[0]); b = __builtin_bit_cast(float, r[1]); }
__device__ __forceinline__ void swap32_f(float v, float& a, float& b) { const auto r = __builtin_amdgcn_permlane32_swap(__builtin_bit_cast(unsigned, v), __builtin_bit_cast(unsigned, v), false, false); a = __builtin_bit_cast(float, r[0]); b = __builtin_bit_cast(float, r[1]); }
__device__ __forceinline__ void swap16_i(int v, int& a, int& b) { const auto r = __builtin_amdgcn_permlane16_swap((unsigned)v, (unsigned)v, false, false); a = (int)r[0]; b = (int)r[1]; }
__device__ __forceinline__ void swap32_i(int v, int& a, int& b) { const auto r = __builtin_amdgcn_permlane32_swap((unsigned)v, (unsigned)v, false, false); a = (int)r[0]; b = (int)r[1]; }
__device__ __forceinline__ float xsum32(float v) { return v + __shfl_xor(v, 32); }
__device__ __forceinline__ float xmax32(float v) { return fmaxf(v, __shfl_xor(v, 32)); }
__device__ __forceinline__ float wave_sum(float v) {
  v += dpp_f<0xB1>(v); v += dpp_f<0x4E>(v); v += dpp_f<0x141>(v); v += dpp_f<0x140>(v);
  v += __shfl_xor(v, 16); v += __shfl_xor(v, 32);
  return v;
}
__device__ __forceinline__ float wave_max(float v) {
#pragma unroll
  for (int o = 1; o < 64; o <<= 1) v = fmaxf(v, __shfl_xor(v, o));
  return v;
}
#define AM_STEP_DPP(C) { const float ov = dpp_f<C>(v); const int oi = dpp_i<C>(idx); if (ov > v || (ov == v && oi < idx)) { v = ov; idx = oi; } }
#define AM3_STEP_DPP(C) { const float ov = dpp_f<C>(v); const int oi = dpp_i<C>(idx); const float op = dpp_f<C>(pay); if (ov > v || (ov == v && oi < idx)) { v = ov; idx = oi; pay = op; } }
__device__ __forceinline__ void wave_argmax(float& v, int& idx) {
  AM_STEP_DPP(0xB1) AM_STEP_DPP(0x4E) AM_STEP_DPP(0x141) AM_STEP_DPP(0x140)
#pragma unroll
  for (int o = 16; o < 64; o <<= 1) {
    const float ov = __shfl_xor(v, o); const int oi = __shfl_xor(idx, o);
    if (ov > v || (ov == v && oi < idx)) { v = ov; idx = oi; }
  }
}
__device__ __forceinline__ void wave_argmax3(float& v, int& idx, float& pay) {
  AM3_STEP_DPP(0xB1) AM3_STEP_DPP(0x4E) AM3_STEP_DPP(0x141) AM3_STEP_DPP(0x140)
#pragma unroll
  for (int o = 16; o < 64; o <<= 1) {
    const float ov = __shfl_xor(v, o); const int oi = __shfl_xor(idx, o); const float op = __shfl_xor(pay, o);
    if (ov > v || (ov == v && oi < idx)) { v = ov; idx = oi; pay = op; }
  }
}
#undef AM_STEP_DPP
#undef AM3_STEP_DPP
#define LDS_FENCE() asm volatile("s_waitcnt lgkmcnt(0)" ::: "memory")

constexpr int A_PITCH = 80, ST_A = 128 * A_PITCH, ST_B = 32 * 256, STAGE = ST_A + ST_B, GEMM_LDS = 2 * STAGE;
template <class AL, class BL>
__device__ __forceinline__ void gemm_core(unsigned char* lds, f32x16 (&acc)[2][2], int m0, int n0, int M, int N, int K, AL aload, BL bload) {
  int tid = threadIdx.x; asm volatile("" : "+v"(tid));
  const int lane = tid & 63, w = tid >> 6, wr = w >> 1, wc = w & 1;
#pragma unroll
  for (int i = 0; i < 2; ++i)
#pragma unroll
    for (int j = 0; j < 2; ++j)
#pragma unroll
      for (int r = 0; r < 16; ++r) acc[i][j][r] = 0.f;
  __syncthreads();
  uint4 av[2]; float4 bv[4];
#define GEMM_GLOAD(k0) do { \
    _Pragma("unroll") for (int i = 0; i < 2; ++i) { const int id = tid + 256 * i, row = id >> 2, kc = id & 3; av[i] = aload(min(m0 + row, M - 1), (k0) + 8 * kc); } \
    _Pragma("unroll") for (int i = 0; i < 4; ++i) { const int id = tid + 256 * i, kr = id >> 5, nq = id & 31; bv[i] = bload((k0) + kr, min(n0 + 4 * nq, N - 4)); } } while (0)
#define GEMM_LSTORE(buf) do { unsigned char* As_ = lds + (buf) * STAGE; unsigned char* Bs_ = As_ + ST_A; \
    _Pragma("unroll") for (int i = 0; i < 2; ++i) { const int id = tid + 256 * i, row = id >> 2, kc = id & 3; *(uint4*)(As_ + row * A_PITCH + kc * 16) = av[i]; } \
    _Pragma("unroll") for (int i = 0; i < 4; ++i) { const int id = tid + 256 * i, kr = id >> 5, n = 4 * (id & 31); \
      uint2 v; v.x = pk2(bv[i].x, bv[i].y); v.y = pk2(bv[i].z, bv[i].w); \
      *(uint2*)(Bs_ + kr * 256 + (((n >> 5) ^ (kr & 3)) << 6) + (n & 31) * 2) = v; } } while (0)
  const int q4 = (lane >> 2) & 3, h = lane >> 5, nk = K >> 5;
  GEMM_GLOAD(0); GEMM_LSTORE(0);
  if (nk > 1) GEMM_GLOAD(32);
  __syncthreads();
#pragma unroll 1
  for (int kt = 0; kt < nk; ++kt) {
    const unsigned char* As = lds + (kt & 1) * STAGE; const unsigned char* Bs = As + ST_A;
#pragma unroll
    for (int ks = 0; ks < 2; ++ks) {
      bf16x8 a[2], b[2];
#pragma unroll
      for (int i = 0; i < 2; ++i) a[i] = *(const bf16x8*)(As + (wr * 64 + i * 32 + (lane & 31)) * A_PITCH + ks * 32 + h * 16);
#pragma unroll
      for (int j = 0; j < 2; ++j) {
        const int k = ks * 16 + 8 * h + q4;
        const unsigned char* pb = Bs + k * 256 + ((((wc * 2 + j)) ^ q4) << 6) + ((lane >> 4) & 1) * 32 + (lane & 3) * 8;
        const v4i16_t lo = __builtin_amdgcn_ds_read_tr16_b64_v4i16((LAS v4i16_t*)pb);
        const v4i16_t hi = __builtin_amdgcn_ds_read_tr16_b64_v4i16((LAS v4i16_t*)(pb + 4 * 256));
        b[j] = __builtin_shufflevector(lo, hi, 0, 1, 2, 3, 4, 5, 6, 7);
      }
#pragma unroll
      for (int i = 0; i < 2; ++i)
#pragma unroll
        for (int j = 0; j < 2; ++j) acc[i][j] = __builtin_amdgcn_mfma_f32_32x32x16_bf16(a[i], b[j], acc[i][j], 0, 0, 0);
    }
    if (kt + 1 < nk) { GEMM_LSTORE((kt + 1) & 1); if (kt + 2 < nk) GEMM_GLOAD((kt + 2) * 32); }
    __syncthreads();
  }
#undef GEMM_GLOAD
#undef GEMM_LSTORE
}
__device__ __forceinline__ float* epi_stage(const f32x16 (&acc)[2][2], unsigned char* lds) {
  int tid_ = threadIdx.x; asm volatile("" : "+v"(tid_));
  const int lane = tid_ & 63, w = tid_ >> 6;
  float* st = (float*)(lds + w * 16384);
#pragma unroll
  for (int i = 0; i < 2; ++i)
#pragma unroll
    for (int j = 0; j < 2; ++j)
#pragma unroll
      for (int r = 0; r < 16; ++r) st[(i * 32 + (r & 3) + 8 * (r >> 2) + 4 * (lane >> 5)) * 64 + j * 32 + (lane & 31)] = acc[i][j][r];
  LDS_FENCE();
  return st;
}
template <class F4>
__device__ __forceinline__ void epi_rows(const f32x16 (&acc)[2][2], unsigned char* lds, int m0, int n0, int M, int N, F4 f) {
  const int lane = threadIdx.x & 63, w = threadIdx.x >> 6, wr = w >> 1, wc = w & 1;
  const float* st = epi_stage(acc, lds);
#pragma unroll 2
  for (int it = 0; it < 16; ++it) {
    const int rl = it * 4 + (lane >> 4), cl = (lane & 15) * 4;
    const float4 v = *(const float4*)(st + rl * 64 + cl);
    const int row = m0 + wr * 64 + rl, col = n0 + wc * 64 + cl;
    if (row < M && col < N) f(row, col, v);
  }
}
template <class F4>
__device__ __forceinline__ void epi_pair_rows(const f32x16 (&acc)[2][2], unsigned char* lds, int m0, int h0, int M, F4 f) {
  const int lane = threadIdx.x & 63, w = threadIdx.x >> 6, wr = w >> 1, wc = w & 1;
  const float* st = epi_stage(acc, lds);
#pragma unroll 2
  for (int it = 0; it < 8; ++it) {
    const int rl = it * 8 + (lane >> 3), cl = (lane & 7) * 4;
    const float4 g = *(const float4*)(st + rl * 64 + cl), u = *(const float4*)(st + rl * 64 + 32 + cl);
    const int row = m0 + wr * 64 + rl;
    if (row < M) f(row, h0 + wc * 32 + cl, g, u);
  }
}
template <class AL, class BL, class EP>
__device__ __forceinline__ void gemm_tile_bf16(unsigned char* lds, int m0, int n0, int M, int N, int K, AL aload, BL bload, EP epi) {
  f32x16 acc[2][2];
  gemm_core(lds, acc, m0, n0, M, N, K, aload, bload);
  epi_rows(acc, lds, m0, n0, M, N, epi);
}
__device__ __forceinline__ void st_bf16x4(bf16* p, float4 v) { uint2 u; u.x = pk2(v.x, v.y); u.y = pk2(v.z, v.w); *(uint2*)p = u; }
__device__ __forceinline__ float4 ld_bf16x4(const bf16* p) { const uint2 u = *(const uint2*)p; return make_float4(__uint_as_float(u.x << 16), __uint_as_float(u.x & 0xffff0000u), __uint_as_float(u.y << 16), __uint_as_float(u.y & 0xffff0000u)); }
__device__ __forceinline__ float4 up_bf16x4(unsigned lo, unsigned hi) { return make_float4(__uint_as_float(lo << 16), __uint_as_float(lo & 0xffff0000u), __uint_as_float(hi << 16), __uint_as_float(hi & 0xffff0000u)); }
__device__ __forceinline__ float4 sig4(float4 v) { return make_float4(sigmoidf_(v.x), sigmoidf_(v.y), sigmoidf_(v.z), sigmoidf_(v.w)); }
__device__ __forceinline__ float4 mul4(float4 a, float4 b) { return make_float4(a.x * b.x, a.y * b.y, a.z * b.z, a.w * b.w); }
__device__ __forceinline__ float4 scale4(float4 a, float s) { return make_float4(a.x * s, a.y * s, a.z * s, a.w * s); }


constexpr int ST2_A = 256 * A_PITCH, ST2_B = 32 * 256, STAGE2 = ST2_A + ST2_B, GEMM2_LDS = 2 * STAGE2;
__device__ __forceinline__ uint2 to_bf16x4(float4 v) { uint2 r; r.x = pk2(v.x, v.y); r.y = pk2(v.z, v.w); return r; }
__device__ __forceinline__ uint2 to_bf16x4(uint2 v) { return v; }
template <class AR, class BL>
__device__ __forceinline__ void gemm256_core(unsigned char* lds, f32x16 (&acc)[4][2], int m0, int n0, int M, int N, int K, AR arow, BL bload) {
  int tid = threadIdx.x; asm volatile("" : "+v"(tid));
  const int lane = tid & 63, w = tid >> 6, wr = w >> 1, wc = w & 1;
#pragma unroll
  for (int i = 0; i < 4; ++i)
#pragma unroll
    for (int j = 0; j < 2; ++j)
#pragma unroll
      for (int r = 0; r < 16; ++r) acc[i][j][r] = 0.f;
  const bf16* ap0 = arow(min(m0 + ((tid) >> 2), M - 1)) + 8 * (tid & 3);
  const bf16* ap1 = arow(min(m0 + ((tid + 256) >> 2), M - 1)) + 8 * (tid & 3);
  const bf16* ap2 = arow(min(m0 + ((tid + 512) >> 2), M - 1)) + 8 * (tid & 3);
  const bf16* ap3 = arow(min(m0 + ((tid + 768) >> 2), M - 1)) + 8 * (tid & 3);
  __syncthreads();
  uint4 av0, av1, av2, av3; decltype(bload(0, 0)) bv0, bv1, bv2, bv3;
  const int bkr = tid >> 5, bcol = min(n0 + 4 * (tid & 31), N - 4);
#define G2_GLOAD(k0) do { av0 = *(const uint4*)(ap0 + (k0)); av1 = *(const uint4*)(ap1 + (k0)); av2 = *(const uint4*)(ap2 + (k0)); av3 = *(const uint4*)(ap3 + (k0)); \
    bv0 = bload((k0) + bkr, bcol); bv1 = bload((k0) + bkr + 8, bcol); bv2 = bload((k0) + bkr + 16, bcol); bv3 = bload((k0) + bkr + 24, bcol); } while (0)
#define G2_LSTORE(buf) do { unsigned char* As_ = lds + (buf) * STAGE2 + (tid >> 2) * A_PITCH + (tid & 3) * 16; \
    *(uint4*)(As_) = av0; *(uint4*)(As_ + 64 * A_PITCH) = av1; *(uint4*)(As_ + 128 * A_PITCH) = av2; *(uint4*)(As_ + 192 * A_PITCH) = av3; \
    const int n_ = 4 * (tid & 31); unsigned char* Bs_ = lds + (buf) * STAGE2 + ST2_A + bkr * 256 + (((n_ >> 5) ^ (bkr & 3)) << 6) + (n_ & 31) * 2; \
    *(uint2*)(Bs_) = to_bf16x4(bv0); *(uint2*)(Bs_ + 8 * 256) = to_bf16x4(bv1); *(uint2*)(Bs_ + 16 * 256) = to_bf16x4(bv2); *(uint2*)(Bs_ + 24 * 256) = to_bf16x4(bv3); } while (0)
  const int q4 = (lane >> 2) & 3, h = lane >> 5, nk = K >> 5;
  G2_GLOAD(0); G2_LSTORE(0);
  if (nk > 1) G2_GLOAD(32);
  __syncthreads();
#pragma unroll 1
  for (int kt = 0; kt < nk; ++kt) {
    const unsigned char* As = lds + (kt & 1) * STAGE2; const unsigned char* Bs = As + ST2_A;
#pragma unroll
    for (int ks = 0; ks < 2; ++ks) {
      bf16x8 a[4], b[2];
#pragma unroll
      for (int i = 0; i < 4; ++i) a[i] = *(const bf16x8*)(As + (wr * 128 + i * 32 + (lane & 31)) * A_PITCH + ks * 32 + h * 16);
#pragma unroll
      for (int j = 0; j < 2; ++j) {
        const int k = ks * 16 + 8 * h + q4;
        const unsigned char* pb = Bs + k * 256 + ((((wc * 2 + j)) ^ q4) << 6) + ((lane >> 4) & 1) * 32 + (lane & 3) * 8;
        const v4i16_t lo = __builtin_amdgcn_ds_read_tr16_b64_v4i16((LAS v4i16_t*)pb);
        const v4i16_t hi = __builtin_amdgcn_ds_read_tr16_b64_v4i16((LAS v4i16_t*)(pb + 4 * 256));
        b[j] = __builtin_shufflevector(lo, hi, 0, 1, 2, 3, 4, 5, 6, 7);
      }
#pragma unroll
      for (int i = 0; i < 4; ++i)
#pragma unroll
        for (int j = 0; j < 2; ++j) acc[i][j] = __builtin_amdgcn_mfma_f32_32x32x16_bf16(a[i], b[j], acc[i][j], 0, 0, 0);
    }
    G2_LSTORE((kt + 1) & 1); __builtin_amdgcn_sched_barrier(0x00E); G2_GLOAD(min(kt + 2, nk - 1) * 32);
    __syncthreads();
  }
#undef G2_GLOAD
#undef G2_LSTORE
}
template <class AR, class BL>
__device__ __forceinline__ void gemm256_core_pf2(unsigned char* lds, f32x16 (&acc)[4][2], int m0, int n0, int M, int N, int K, AR arow, BL bload) {
  int tid = threadIdx.x; asm volatile("" : "+v"(tid));
  const int lane = tid & 63, w = tid >> 6, wr = w >> 1, wc = w & 1;
#pragma unroll
  for (int i = 0; i < 4; ++i)
#pragma unroll
    for (int j = 0; j < 2; ++j)
#pragma unroll
      for (int r = 0; r < 16; ++r) acc[i][j][r] = 0.f;
  const bf16* ap0 = arow(min(m0 + ((tid) >> 2), M - 1)) + 8 * (tid & 3);
  const bf16* ap1 = arow(min(m0 + ((tid + 256) >> 2), M - 1)) + 8 * (tid & 3);
  const bf16* ap2 = arow(min(m0 + ((tid + 512) >> 2), M - 1)) + 8 * (tid & 3);
  const bf16* ap3 = arow(min(m0 + ((tid + 768) >> 2), M - 1)) + 8 * (tid & 3);
  __syncthreads();
  uint4 a00, a01, a02, a03, a10, a11, a12, a13; decltype(bload(0, 0)) b00, b01, b02, b03, b10, b11, b12, b13;
  const int bkr = tid >> 5, bcol = min(n0 + 4 * (tid & 31), N - 4);
#define P2_GLOAD(S, k0) do { a##S##0 = *(const uint4*)(ap0 + (k0)); a##S##1 = *(const uint4*)(ap1 + (k0)); a##S##2 = *(const uint4*)(ap2 + (k0)); a##S##3 = *(const uint4*)(ap3 + (k0)); \
    b##S##0 = bload((k0) + bkr, bcol); b##S##1 = bload((k0) + bkr + 8, bcol); b##S##2 = bload((k0) + bkr + 16, bcol); b##S##3 = bload((k0) + bkr + 24, bcol); } while (0)
#define P2_LSTORE(S, buf) do { unsigned char* As_ = lds + (buf) * STAGE2 + (tid >> 2) * A_PITCH + (tid & 3) * 16; \
    *(uint4*)(As_) = a##S##0; *(uint4*)(As_ + 64 * A_PITCH) = a##S##1; *(uint4*)(As_ + 128 * A_PITCH) = a##S##2; *(uint4*)(As_ + 192 * A_PITCH) = a##S##3; \
    const int n_ = 4 * (tid & 31); unsigned char* Bs_ = lds + (buf) * STAGE2 + ST2_A + bkr * 256 + (((n_ >> 5) ^ (bkr & 3)) << 6) + (n_ & 31) * 2; \
    *(uint2*)(Bs_) = to_bf16x4(b##S##0); *(uint2*)(Bs_ + 8 * 256) = to_bf16x4(b##S##1); *(uint2*)(Bs_ + 16 * 256) = to_bf16x4(b##S##2); *(uint2*)(Bs_ + 24 * 256) = to_bf16x4(b##S##3); } while (0)
  const int q4 = (lane >> 2) & 3, h = lane >> 5, nk = K >> 5;
#define P2_COMPUTE(buf) do { const unsigned char* As = lds + (buf) * STAGE2; const unsigned char* Bs = As + ST2_A; \
    _Pragma("unroll") for (int ks = 0; ks < 2; ++ks) { \
      bf16x8 a[4], b[2]; \
      _Pragma("unroll") for (int i = 0; i < 4; ++i) a[i] = *(const bf16x8*)(As + (wr * 128 + i * 32 + (lane & 31)) * A_PITCH + ks * 32 + h * 16); \
      _Pragma("unroll") for (int j = 0; j < 2; ++j) { \
        const int k = ks * 16 + 8 * h + q4; \
        const unsigned char* pb = Bs + k * 256 + ((((wc * 2 + j)) ^ q4) << 6) + ((lane >> 4) & 1) * 32 + (lane & 3) * 8; \
        const v4i16_t lo = __builtin_amdgcn_ds_read_tr16_b64_v4i16((LAS v4i16_t*)pb); \
        const v4i16_t hi = __builtin_amdgcn_ds_read_tr16_b64_v4i16((LAS v4i16_t*)(pb + 4 * 256)); \
        b[j] = __builtin_shufflevector(lo, hi, 0, 1, 2, 3, 4, 5, 6, 7); } \
      _Pragma("unroll") for (int i = 0; i < 4; ++i) \
        _Pragma("unroll") for (int j = 0; j < 2; ++j) acc[i][j] = __builtin_amdgcn_mfma_f32_32x32x16_bf16(a[i], b[j], acc[i][j], 0, 0, 0); } } while (0)
  P2_GLOAD(0, 0); P2_LSTORE(0, 0); P2_GLOAD(1, 32); P2_GLOAD(0, 64);
  __syncthreads();
#pragma unroll 1
  for (int kt = 0; kt < nk; kt += 2) {
    P2_COMPUTE(0);
    P2_LSTORE(1, 1); if (kt + 3 < nk) P2_GLOAD(1, (kt + 3) * 32);
    __syncthreads();
    P2_COMPUTE(1);
    if (kt + 2 < nk) { P2_LSTORE(0, 0); if (kt + 4 < nk) P2_GLOAD(0, (kt + 4) * 32); }
    __syncthreads();
  }
#undef P2_GLOAD
#undef P2_LSTORE
#undef P2_COMPUTE
}
template <class F4>
__device__ __forceinline__ void epi256_rows(const f32x16 (&acc)[4][2], unsigned char* lds, int m0, int n0, int M, int N, F4 f) {
  int tid_ = threadIdx.x; asm volatile("" : "+v"(tid_));
  const int lane = tid_ & 63, w = tid_ >> 6, wr = w >> 1, wc = w & 1;
  float* st = (float*)(lds + w * 16384);
#pragma unroll
  for (int hf = 0; hf < 2; ++hf) {
#pragma unroll
    for (int i = 0; i < 2; ++i)
#pragma unroll
      for (int j = 0; j < 2; ++j)
#pragma unroll
        for (int r = 0; r < 16; ++r) st[(i * 32 + (r & 3) + 8 * (r >> 2) + 4 * (lane >> 5)) * 64 + j * 32 + (lane & 31)] = acc[2 * hf + i][j][r];
    LDS_FENCE();
#pragma unroll 8
    for (int it = 0; it < 16; ++it) {
      const int rl = it * 4 + (lane >> 4), cl = (lane & 15) * 4;
      const float4 v = *(const float4*)(st + rl * 64 + cl);
      const int row = m0 + wr * 128 + hf * 64 + rl, col = n0 + wc * 64 + cl;
      if (row < M && col < N) f(row, col, v);
    }
    LDS_FENCE();
  }
}
template <class PRE, class F4>
__device__ __forceinline__ void epi256_rows_pre(const f32x16 (&acc)[4][2], unsigned char* lds, int m0, int n0, int M, int N, PRE pre, F4 f) {
  int tid_ = threadIdx.x; asm volatile("" : "+v"(tid_));
  const int lane = tid_ & 63, w = tid_ >> 6, wr = w >> 1, wc = w & 1;
  float* st = (float*)(lds + w * 16384);
  const int cl = (lane & 15) * 4, col = n0 + wc * 64 + cl;
#pragma unroll
  for (int hf = 0; hf < 2; ++hf) {
    uint4 pv[16];
#pragma unroll
    for (int it = 0; it < 16; ++it) { const int row = m0 + wr * 128 + hf * 64 + it * 4 + (lane >> 4); pv[it] = pre(min(row, M - 1), min(col, N - 4)); }
#pragma unroll
    for (int i = 0; i < 2; ++i)
#pragma unroll
      for (int j = 0; j < 2; ++j)
#pragma unroll
        for (int r = 0; r < 16; ++r) st[(i * 32 + (r & 3) + 8 * (r >> 2) + 4 * (lane >> 5)) * 64 + j * 32 + (lane & 31)] = acc[2 * hf + i][j][r];
    LDS_FENCE();
#pragma unroll
    for (int it = 0; it < 16; ++it) {
      const int rl = it * 4 + (lane >> 4);
      const float4 v = *(const float4*)(st + rl * 64 + cl);
      const int row = m0 + wr * 128 + hf * 64 + rl;
      if (row < M && col < N) f(row, col, v, pv[it]);
    }
    LDS_FENCE();
  }
}
template <class PRE, class F8>
__device__ __forceinline__ void epi256_rows_pre16(const f32x16 (&acc)[4][2], unsigned char* lds, int m0, int n0, int M, int N, PRE pre, F8 f) {
  int tid_ = threadIdx.x; asm volatile("" : "+v"(tid_));
  const int lane = tid_ & 63, w = tid_ >> 6, wr = w >> 1, wc = w & 1;
  float* st = (float*)(lds + w * 16384);
  const int cl = (lane & 7) * 8, col = n0 + wc * 64 + cl, sw = ((lane >> 3) & 1) * 4;
#pragma unroll
  for (int hf = 0; hf < 2; ++hf) {
    uint4 pv[8];
#pragma unroll
    for (int it = 0; it < 8; ++it) { const int row = m0 + wr * 128 + hf * 64 + it * 8 + (lane >> 3); pv[it] = pre(min(row, M - 1), min(col, N - 8)); }
#pragma unroll
    for (int i = 0; i < 2; ++i)
#pragma unroll
      for (int j = 0; j < 2; ++j)
#pragma unroll
        for (int r = 0; r < 16; ++r) st[(i * 32 + (r & 3) + 8 * (r >> 2) + 4 * (lane >> 5)) * 64 + j * 32 + (lane & 31)] = acc[2 * hf + i][j][r];
    LDS_FENCE();
#pragma unroll
    for (int it = 0; it < 8; ++it) {
      const int rl = it * 8 + (lane >> 3);
      const float4 p0 = *(const float4*)(st + rl * 64 + cl + sw), p1 = *(const float4*)(st + rl * 64 + cl + 4 - sw);
      const float4 a = sw ? p1 : p0, b = sw ? p0 : p1;
      const int row = m0 + wr * 128 + hf * 64 + rl;
      if (row < M && col < N) f(row, col, a, b, pv[it]);
    }
    LDS_FENCE();
  }
}
template <class F8>
__device__ __forceinline__ void epi256_rows_tok16(const f32x16 (&acc)[4][2], unsigned char* lds, int m0, int n0, int M, int N, const int (&tk0)[8], const int (&tk1)[8], F8 f) {
  int tid_ = threadIdx.x; asm volatile("" : "+v"(tid_));
  const int lane = tid_ & 63, w = tid_ >> 6, wr = w >> 1, wc = w & 1;
  float* st = (float*)(lds + w * 16384);
  const int cl = (lane & 7) * 8, col = n0 + wc * 64 + cl, sw = ((lane >> 3) & 1) * 4;
#pragma unroll
  for (int hf = 0; hf < 2; ++hf) {
#pragma unroll
    for (int i = 0; i < 2; ++i)
#pragma unroll
      for (int j = 0; j < 2; ++j)
#pragma unroll
        for (int r = 0; r < 16; ++r) st[(i * 32 + (r & 3) + 8 * (r >> 2) + 4 * (lane >> 5)) * 64 + j * 32 + (lane & 31)] = acc[2 * hf + i][j][r];
    LDS_FENCE();
#pragma unroll
    for (int it = 0; it < 8; ++it) {
      const int rl = it * 8 + (lane >> 3);
      const float4 p0 = *(const float4*)(st + rl * 64 + cl + sw), p1 = *(const float4*)(st + rl * 64 + cl + 4 - sw);
      const float4 a = sw ? p1 : p0, b = sw ? p0 : p1;
      const int row = m0 + wr * 128 + hf * 64 + rl;
      if (row < M && col < N) f(row, col, a, b, hf ? tk1[it] : tk0[it]);
    }
    LDS_FENCE();
  }
}
template <class F8>
__device__ __forceinline__ void epi256_rows16(const f32x16 (&acc)[4][2], unsigned char* lds, int m0, int n0, int M, int N, F8 f) {
  int tid_ = threadIdx.x; asm volatile("" : "+v"(tid_));
  const int lane = tid_ & 63, w = tid_ >> 6, wr = w >> 1, wc = w & 1;
  float* st = (float*)(lds + w * 16384);
  const int cl = (lane & 7) * 8, col = n0 + wc * 64 + cl, sw = ((lane >> 3) & 1) * 4;
#pragma unroll
  for (int hf = 0; hf < 2; ++hf) {
#pragma unroll
    for (int i = 0; i < 2; ++i)
#pragma unroll
      for (int j = 0; j < 2; ++j)
#pragma unroll
        for (int r = 0; r < 16; ++r) st[(i * 32 + (r & 3) + 8 * (r >> 2) + 4 * (lane >> 5)) * 64 + j * 32 + (lane & 31)] = acc[2 * hf + i][j][r];
    LDS_FENCE();
#pragma unroll
    for (int it = 0; it < 8; ++it) {
      const int rl = it * 8 + (lane >> 3);
      const float4 p0 = *(const float4*)(st + rl * 64 + cl + sw), p1 = *(const float4*)(st + rl * 64 + cl + 4 - sw);
      const float4 a = sw ? p1 : p0, b = sw ? p0 : p1;
      const int row = m0 + wr * 128 + hf * 64 + rl;
      if (row < M && col < N) f(row, col, a, b);
    }
    LDS_FENCE();
  }
}
__device__ __forceinline__ void st_bf16x8(bf16* p, float4 a, float4 b) { uint4 u; u.x = pk2(a.x, a.y); u.y = pk2(a.z, a.w); u.z = pk2(b.x, b.y); u.w = pk2(b.z, b.w); *(uint4*)p = u; }
template <class F4>
__device__ __forceinline__ void epi256_pair_rows(const f32x16 (&acc)[4][2], unsigned char* lds, int m0, int h0, int M, F4 f) {
  int tid_ = threadIdx.x; asm volatile("" : "+v"(tid_));
  const int lane = tid_ & 63, w = tid_ >> 6, wr = w >> 1, wc = w & 1;
  float* st = (float*)(lds + w * 16384);
#pragma unroll
  for (int hf = 0; hf < 2; ++hf) {
#pragma unroll
    for (int i = 0; i < 2; ++i)
#pragma unroll
      for (int j = 0; j < 2; ++j)
#pragma unroll
        for (int r = 0; r < 16; ++r) st[(i * 32 + (r & 3) + 8 * (r >> 2) + 4 * (lane >> 5)) * 64 + j * 32 + (lane & 31)] = acc[2 * hf + i][j][r];
    LDS_FENCE();
#pragma unroll 2
    for (int it = 0; it < 8; ++it) {
      const int rl = it * 8 + (lane >> 3), cl = (lane & 7) * 4;
      const float4 g = *(const float4*)(st + rl * 64 + cl), u = *(const float4*)(st + rl * 64 + 32 + cl);
      const int row = m0 + wr * 128 + hf * 64 + rl;
      if (row < M) f(row, h0 + wc * 32 + cl, g, u);
    }
    LDS_FENCE();
  }
}
template <class AR, class BL, class PRE, class EP>
__device__ __forceinline__ void gemm256_tile_pre(unsigned char* lds, int m0, int n0, int M, int N, int K, AR arow, BL bload, PRE pre, EP epi) {
  f32x16 acc[4][2];
  gemm256_core(lds, acc, m0, n0, M, N, K, arow, bload);
  epi256_rows_pre(acc, lds, m0, n0, M, N, pre, epi);
}
template <class AR, class BL, class PRE, class EP>
__device__ __forceinline__ void gemm256_tile_pre_pf2(unsigned char* lds, int m0, int n0, int M, int N, int K, AR arow, BL bload, PRE pre, EP epi) {
  f32x16 acc[4][2];
  gemm256_core_pf2(lds, acc, m0, n0, M, N, K, arow, bload);
  epi256_rows_pre(acc, lds, m0, n0, M, N, pre, epi);
}
template <class AR, class BL, class EP>
__device__ __forceinline__ void gemm256_tile(unsigned char* lds, int m0, int n0, int M, int N, int K, AR arow, BL bload, EP epi) {
  f32x16 acc[4][2];
  gemm256_core(lds, acc, m0, n0, M, N, K, arow, bload);
  epi256_rows(acc, lds, m0, n0, M, N, epi);
}

template <class LD>
__device__ __forceinline__ void rms_mod_row_t(LD ld, const float* g, const float* sc, const float* sh, bf16* orow, int lane) {
  float4 v[4]; float s = 0.f;
#pragma unroll
  for (int j = 0; j < 4; ++j) { v[j] = ld(lane + 64 * j); s += v[j].x * v[j].x + v[j].y * v[j].y + v[j].z * v[j].z + v[j].w * v[j].w; }
  s = wave_sum(s);
  const float rs = rsqrtf(s * (1.f / D) + 1e-6f);
#pragma unroll
  for (int j = 0; j < 4; ++j) {
    const float4 gg = ((const float4*)g)[lane + 64 * j], cc = ((const float4*)sc)[lane + 64 * j], hh = ((const float4*)sh)[lane + 64 * j];
    float4 o;
    o.x = v[j].x * rs * gg.x * (1.f + cc.x) + hh.x; o.y = v[j].y * rs * gg.y * (1.f + cc.y) + hh.y;
    o.z = v[j].z * rs * gg.z * (1.f + cc.z) + hh.z; o.w = v[j].w * rs * gg.w * (1.f + cc.w) + hh.w;
    uint2 ov; ov.x = pk2(o.x, o.y); ov.y = pk2(o.z, o.w); ((uint2*)orow)[lane + 64 * j] = ov;
  }
}
__device__ __forceinline__ float4 bf4_to_f4(uint2 e) { return make_float4(__uint_as_float(e.x << 16), __uint_as_float(e.x & 0xffff0000u), __uint_as_float(e.y << 16), __uint_as_float(e.y & 0xffff0000u)); }
__device__ __forceinline__ void rms_mod_row(const float* xr, const float* g, const float* sc, const float* sh, bf16* orow, int lane) {
  rms_mod_row_t([&](int i) { return ((const float4*)xr)[i]; }, g, sc, sh, orow, lane);
}
__device__ __forceinline__ void rms_mod_row_b(const bf16* xr, const float* g, const float* sc, const float* sh, bf16* orow, int lane) {
  rms_mod_row_t([&](int i) { return bf4_to_f4(((const uint2*)xr)[i]); }, g, sc, sh, orow, lane);
}

constexpr float LOG2E = 1.4426950408889634f;
constexpr int KL_PITCH = 144, KL_BYTES = 64 * KL_PITCH, VL_BYTES = 64 * 128;
constexpr int NSA_OUT_OFF = KL_BYTES + VL_BYTES + 16384 + 512 + 32 + 144;
constexpr int KV2_OFF = NSA_OUT_OFF + 16 * 256 * 4, ATT_LDS = KV2_OFF + KL_BYTES + VL_BYTES;
struct StageRegs { uint4 k0, k1, v0, v1; };
__device__ __forceinline__ void stage_load(const bf16* Kg, const bf16* Vg, StageRegs& r, int tid) {
  r.k0 = ((const uint4*)Kg)[tid]; r.k1 = ((const uint4*)Kg)[tid + 256]; r.v0 = ((const uint4*)Vg)[tid]; r.v1 = ((const uint4*)Vg)[tid + 256];
}
__device__ __forceinline__ void stage_store(unsigned char* Kl, unsigned char* Vl, const StageRegs& r, int tid) {
  { const int id = tid, row = id >> 3, c8 = id & 7;
    *(uint4*)(Kl + row * KL_PITCH + c8 * 16) = r.k0;
    *(uint4*)(Vl + row * 128 + ((((c8 >> 2) ^ ((row >> 1) & 1))) << 6) + (c8 & 3) * 16) = r.v0; }
  { const int id = tid + 256, row = id >> 3, c8 = id & 7;
    *(uint4*)(Kl + row * KL_PITCH + c8 * 16) = r.k1;
    *(uint4*)(Vl + row * 128 + ((((c8 >> 2) ^ ((row >> 1) & 1))) << 6) + (c8 & 3) * 16) = r.v1; }
}
__device__ __forceinline__ void qk_tile(const unsigned char* Kl, const bf16x8 (&qf)[4], f32x16 (&Sx)[2], int lane) {
#pragma unroll
  for (int kb = 0; kb < 2; ++kb)
#pragma unroll
    for (int r = 0; r < 16; ++r) Sx[kb][r] = 0.f;
#pragma unroll
  for (int ks = 0; ks < 4; ++ks) {
    bf16x8 a[2];
#pragma unroll
    for (int kb = 0; kb < 2; ++kb) a[kb] = *(const bf16x8*)(Kl + (kb * 32 + (lane & 31)) * KL_PITCH + ks * 32 + (lane >> 5) * 16);
#pragma unroll
    for (int kb = 0; kb < 2; ++kb) Sx[kb] = __builtin_amdgcn_mfma_f32_32x32x16_bf16(a[kb], qf[ks], Sx[kb], 0, 0, 0);
  }
}
__device__ __forceinline__ void pv_tile(const unsigned char* Vl, const f32x16 (&P)[2], f32x16 (&O)[2], int lane) {
  const int h = lane >> 5, q = (lane >> 2) & 3, pp = lane & 3, g16 = (lane >> 4) & 1;
#pragma unroll
  for (int kb = 0; kb < 2; ++kb)
#pragma unroll
    for (int s2 = 0; s2 < 2; ++s2) {
      uint4 pk; pk.x = pk2(P[kb][8 * s2 + 0], P[kb][8 * s2 + 1]); pk.y = pk2(P[kb][8 * s2 + 2], P[kb][8 * s2 + 3]);
      pk.z = pk2(P[kb][8 * s2 + 4], P[kb][8 * s2 + 5]); pk.w = pk2(P[kb][8 * s2 + 6], P[kb][8 * s2 + 7]);
      const bf16x8 pf = __builtin_bit_cast(bf16x8, pk);
#pragma unroll
      for (int db = 0; db < 2; ++db) {
        const unsigned char* pa = Vl + (kb * 32 + 16 * s2 + 4 * h + q) * 128 + ((db ^ (q >> 1)) << 6) + (16 * g16 + 4 * pp) * 2;
        const v4i16_t lo = __builtin_amdgcn_ds_read_tr16_b64_v4i16((LAS v4i16_t*)pa);
        const v4i16_t hi = __builtin_amdgcn_ds_read_tr16_b64_v4i16((LAS v4i16_t*)(pa + 8 * 128));
        const bf16x8 vf = __builtin_shufflevector(lo, hi, 0, 1, 2, 3, 4, 5, 6, 7);
        O[db] = __builtin_amdgcn_mfma_f32_32x32x16_bf16(vf, pf, O[db], 0, 0, 0);
      }
    }
}
__device__ __forceinline__ void mfma_settle(f32x16 (&Sx)[2], float& slopek) {
  float e0 = Sx[0][15], e1 = Sx[1][15];
  asm volatile("s_nop 7\n\ts_nop 7\n\ts_nop 3" : "+v"(slopek), "+v"(e0), "+v"(e1));
  Sx[0][15] = e0; Sx[1][15] = e1;
}
template <int MODE, int I>
struct BiasStep {
  static __device__ __forceinline__ void run(f32x16 (&Sx)[2], float slopek, int lim_hi, int lim_lo) {
    constexpr int kb = I >> 4, r = I & 15, c = kb * 32 + (r & 3) + 8 * (r >> 2);
    float s;
    asm("v_fmamk_f32 %0, %1, %2, %3" : "=v"(s) : "v"(slopek), "n"(__builtin_bit_cast(int, (float)c)), "v"(Sx[kb][r]));
    if (MODE & 1) s = (c > lim_hi) ? -INFINITY : s;
    if (MODE & 2) s = (c <= lim_lo) ? -INFINITY : s;
    Sx[kb][r] = s;
    BiasStep<MODE, I + 1>::run(Sx, slopek, lim_hi, lim_lo);
  }
};
template <int MODE>
struct BiasStep<MODE, 32> { static __device__ __forceinline__ void run(f32x16 (&)[2], float, int, int) {} };
template <int MODE>
__device__ __forceinline__ void bias_mask(f32x16 (&Sx)[2], float slopek, int lim_hi, int lim_lo) {
  mfma_settle(Sx, slopek);
  BiasStep<MODE, 0>::run(Sx, slopek, lim_hi, lim_lo);
}
__device__ __forceinline__ float vmax3(float a, float b, float c) { float d; asm("v_max3_f32 %0, %1, %2, %3" : "=v"(d) : "v"(a), "v"(b), "v"(c)); return d; }
__device__ __forceinline__ float tile_max(const f32x16 (&Sx)[2]) {
  float m0 = vmax3(Sx[0][0], Sx[0][1], Sx[0][2]), m1 = vmax3(Sx[1][0], Sx[1][1], Sx[1][2]);
  m0 = vmax3(m0, Sx[0][3], Sx[0][4]); m1 = vmax3(m1, Sx[1][3], Sx[1][4]);
  m0 = vmax3(m0, Sx[0][5], Sx[0][6]); m1 = vmax3(m1, Sx[1][5], Sx[1][6]);
  m0 = vmax3(m0, Sx[0][7], Sx[0][8]); m1 = vmax3(m1, Sx[1][7], Sx[1][8]);
  m0 = vmax3(m0, Sx[0][9], Sx[0][10]); m1 = vmax3(m1, Sx[1][9], Sx[1][10]);
  m0 = vmax3(m0, Sx[0][11], Sx[0][12]); m1 = vmax3(m1, Sx[1][11], Sx[1][12]);
  m0 = vmax3(m0, Sx[0][13], Sx[0][14]); m1 = vmax3(m1, Sx[1][13], Sx[1][14]);
  return vmax3(m0, m1, fmaxf(Sx[0][15], Sx[1][15]));
}
__device__ __forceinline__ void exp_sum2(float& s0, float& s1, float& l0, float& l1, float t) {
  asm("v_add_f32 %0, %0, %4\n\tv_add_f32 %1, %1, %4\n\tv_exp_f32 %0, %0\n\tv_exp_f32 %1, %1\n\tv_add_f32 %2, %2, %0\n\tv_add_f32 %3, %3, %1"
      : "+v"(s0), "+v"(s1), "+v"(l0), "+v"(l1) : "v"(t));
}
__device__ __forceinline__ void exp_scale2(float& s0, float& s1, float t, float inv) {
  asm("v_add_f32 %0, %0, %2\n\tv_add_f32 %1, %1, %2\n\tv_exp_f32 %0, %0\n\tv_exp_f32 %1, %1\n\tv_mul_f32 %0, %0, %3\n\tv_mul_f32 %1, %1, %3\n\ts_nop 1"
      : "+v"(s0), "+v"(s1) : "v"(t), "v"(inv));
}
__device__ __forceinline__ void online_update(f32x16 (&Sx)[2], f32x16 (&O)[2], float& m, float& l, float sbh) {
  const float mx = xmax32(tile_max(Sx) + sbh);
  if (__ballot(mx > m + 8.f) != 0ull) {
    const float mn = fmaxf(m, mx);
    const float ms = (mn == -INFINITY) ? 0.f : mn;
    const float alpha = __builtin_amdgcn_exp2f(m - ms);
    l *= alpha; m = mn;
#pragma unroll
    for (int db = 0; db < 2; ++db)
#pragma unroll
      for (int r = 0; r < 16; ++r) O[db][r] *= alpha;
  }
  const float t = sbh - ((m == -INFINITY) ? 0.f : m);
  float ls0 = 0.f, ls1 = 0.f;
#pragma unroll
  for (int r = 0; r < 16; ++r) {
    float p0 = Sx[0][r], p1 = Sx[1][r];
    exp_sum2(p0, p1, ls0, ls1, t);
    Sx[0][r] = p0; Sx[1][r] = p1;
  }
  l += ls0 + ls1;
}
template <class OFF, class BODY>
__device__ __forceinline__ void tile_loop_pre(unsigned char*& Kl, unsigned char*& Vl, const bf16* Kg, const bf16* Vg, int n, int tid, OFF off, BODY body, StageRegs s0, StageRegs s1);
template <class OFF, class BODY>
__device__ __forceinline__ void tile_loop(unsigned char*& Kl, unsigned char*& Vl, const bf16* Kg, const bf16* Vg, int n, int tid, OFF off, BODY body) {
  StageRegs s0, s1;
  s0.k0 = s0.k1 = s0.v0 = s0.v1 = make_uint4(0, 0, 0, 0); s1 = s0;
  if (n > 0) { const size_t o = off(0); stage_load(Kg + o, Vg + o, s0, tid); }
  if (n > 1) { const size_t o = off(1); stage_load(Kg + o, Vg + o, s1, tid); }
  tile_loop_pre(Kl, Vl, Kg, Vg, n, tid, off, body, s0, s1);
}
template <class OFF, class BODY>
__device__ __forceinline__ void tile_loop_pre(unsigned char*& Kl, unsigned char*& Vl, const bf16* Kg, const bf16* Vg, int n, int tid, OFF off, BODY body, StageRegs s0, StageRegs s1) {
  unsigned char* const K0 = Kl; unsigned char* const V0 = Vl;
  __syncthreads();
  for (int it = 0; it < n; it += 2) {
    stage_store(K0, V0, s0, tid); __syncthreads();
    if (it + 2 < n) { const size_t o = off(it + 2); stage_load(Kg + o, Vg + o, s0, tid); }
    Kl = K0; Vl = V0;
    body(it);
    if (it + 1 < n) {
      stage_store(K0 + KV2_OFF, V0 + KV2_OFF, s1, tid); __syncthreads();
      if (it + 3 < n) { const size_t o = off(it + 3); stage_load(Kg + o, Vg + o, s1, tid); }
      Kl = K0 + KV2_OFF; Vl = V0 + KV2_OFF;
      body(it + 1);
    }
  }
  Kl = K0; Vl = V0;
}
__device__ __forceinline__ int nvalid_cmp(int s) { return s >= 31 ? min(NC, (s - 31) / 16 + 1) : 0; }

__device__ __forceinline__ void nsa_unit(const WS& w, unsigned char* lds, int unit) {
  int tid = threadIdx.x; asm volatile("" : "+v"(tid));
  const int lane = tid & 63, wv = tid >> 6, h = lane >> 5;
  unsigned char* Kl = lds; unsigned char* Vl = lds + KL_BYTES;
  float* imp = (float*)(lds + KL_BYTES + VL_BYTES);
  unsigned short* selm = (unsigned short*)(lds + KL_BYTES + VL_BYTES + 16384);
  unsigned* uni = (unsigned*)(lds + KL_BYTES + VL_BYTES + 16384 + 512);
  unsigned char* tlist = lds + KL_BYTES + VL_BYTES + 16384 + 512 + 32;
  const int pairi = unit >> 1, bh = pairi >> 7, cc = pairi & 127;
  const int c32 = ((unit ^ (unit >> 9)) & 1) ? (255 - cc) : cc;
  const int b = bh >> 1, kvh = bh & 1;
  const int s0 = c32 * 32, cur = s0 >> 6;
  const int col = lane & 31, qi = col >> 2, g = col & 3, hq = kvh * 4 + g;
  const int sq = s0 + wv * 8 + qi, t = b * S + sq, ql = sq & 63;
  const float slope2 = slope_a(hq) * LOG2E;
  bf16x8 qf[4];
#pragma unroll
  for (int ks = 0; ks < 4; ++ks) qf[ks] = *(const bf16x8*)(w.qa() + (size_t)t * 512 + hq * 64 + ks * 16 + 8 * h);
  const float* gap = w.ga() + (size_t)t * 24 + hq * 3;
  const float gate_c = gap[0], gate_s = gap[1], gate_w = gap[2];
  const bf16* kcg = w.kcb() + (size_t)(0 * 4 + bh) * 512 * 64;
  const bf16* vcg = w.kcb() + (size_t)(1 * 4 + bh) * 512 * 64;
  const bf16* ksg = w.kva() + (size_t)((2 * 2 + b) * 2 + kvh) * S * 64;
  const bf16* vsg = w.kva() + (size_t)((3 * 2 + b) * 2 + kvh) * S * 64;
  const bf16* kwg = w.kva() + (size_t)((4 * 2 + b) * 2 + kvh) * S * 64;
  const bf16* vwg = w.kva() + (size_t)((5 * 2 + b) * 2 + kvh) * S * 64;
  unsigned* outl = (unsigned*)(lds + NSA_OUT_OFF) + tid;
#pragma unroll
  for (int i = 0; i < 16; ++i) imp[wv * 1024 + lane + 64 * i] = 0.f;
  if (tid < 8) uni[tid] = 0u;
  f32x16 Sx[2], O[2];
  {
    const int ntc = (nvalid_cmp(s0 + 31) + 63) >> 6;
    const int nvq = nvalid_cmp(sq);
    float m = -INFINITY, l = 0.f;
    const float slope16 = slope2 * 16.f;
    tile_loop(Kl, Vl, kcg, vcg, ntc, tid, [&](int i) { return (size_t)i * 4096; }, [&](int ct) {
      qk_tile(Kl, qf, Sx, lane);
      const float sbc = slope2 * (16.f * (float)(ct * 64 + 4 * h) + 15.5f - (float)sq);
      bias_mask<1>(Sx, slope16, nvq - ct * 64 - 4 * h - 1, 0);
      const float mn = fmaxf(m, xmax32(tile_max(Sx) + sbc));
      const float ms = (mn == -INFINITY) ? 0.f : mn;
      const float tc = sbc - ms;
      float ls0 = 0.f, ls1 = 0.f;
#pragma unroll
      for (int r = 0; r < 16; ++r) { float p0 = Sx[0][r], p1 = Sx[1][r]; exp_sum2(p0, p1, ls0, ls1, tc); }
      l = l * __builtin_amdgcn_exp2f(m - ms) + (ls0 + ls1); m = mn;
    });
    l = xsum32(l);
    const float ms = (m == -INFINITY) ? 0.f : m;
    const float inv = 1.f / fmaxf(l, 1e-30f);
#pragma unroll
    for (int db = 0; db < 2; ++db)
#pragma unroll
      for (int r = 0; r < 16; ++r) O[db][r] = 0.f;
    tile_loop(Kl, Vl, kcg, vcg, ntc, tid, [&](int i) { return (size_t)i * 4096; }, [&](int ct) {
      qk_tile(Kl, qf, Sx, lane);
      bias_mask<1>(Sx, slope16, nvq - ct * 64 - 4 * h - 1, 0);
      const float tc = slope2 * (16.f * (float)(ct * 64 + 4 * h) + 15.5f - (float)sq) - ms;
#pragma unroll
      for (int r = 0; r < 16; ++r) { float p0 = Sx[0][r], p1 = Sx[1][r]; exp_scale2(p0, p1, tc, inv); Sx[0][r] = p0; Sx[1][r] = p1; }
      pv_tile(Vl, Sx, O, lane);
      float* impq = imp + (wv * 8 + qi) * 128;
#pragma unroll
      for (int kb = 0; kb < 2; ++kb)
#pragma unroll
        for (int a = 0; a < 4; ++a) {
          float pq[4];
#pragma unroll
          for (int u = 0; u < 4; ++u) { float v = Sx[kb][4 * a + u]; v += dpp_f<0xB1>(v); v += dpp_f<0x4E>(v); pq[u] = v; }
          const int jb = ct * 16 + kb * 8 + 2 * a + h;
          if (g == 0) {
            atomicAdd(&impq[jb], pq[0] + pq[0] + pq[1] + pq[1] + pq[2] + pq[2] + pq[3]);
            if (jb + 1 < 128) atomicAdd(&impq[jb + 1], pq[3]);
          }
        }
    });
#pragma unroll
    for (int db = 0; db < 2; ++db)
#pragma unroll
      for (int r = 0; r < 16; r += 2) { const float gc = gate_c; outl[256 * (db * 8 + (r >> 1))] = pk2(gc * O[db][r], gc * O[db][r + 1]); }
  }
  LDS_FENCE();
  {
    const int qi2 = lane >> 3, sub = lane & 7;
    const float* impq = imp + (wv * 8 + qi2) * 128 + sub * 16;
    float vals[16]; unsigned m16 = 0u;
#pragma unroll
    for (int u = 0; u < 16; ++u) {
      const int j = sub * 16 + u;
      float v = impq[u];
      if (j == 0 || j >= cur - 1) v = -INFINITY;
      vals[u] = v;
      if (j == 0 || j == cur - 1 || j == cur || (cur < 16 && j <= cur)) m16 |= 1u << u;
    }
    if (cur >= 16) {
      for (int round = 0; round < 13; ++round) {
        float bv = vals[0]; int bj = sub * 16;
#pragma unroll
        for (int u = 1; u < 16; ++u) if (vals[u] > bv) { bv = vals[u]; bj = sub * 16 + u; }
        { const float ov = dpp_f<0xB1>(bv); const int oj = dpp_i<0xB1>(bj); if (ov > bv || (ov == bv && oj < bj)) { bv = ov; bj = oj; } }
        { const float ov = dpp_f<0x4E>(bv); const int oj = dpp_i<0x4E>(bj); if (ov > bv || (ov == bv && oj < bj)) { bv = ov; bj = oj; } }
        { const float ov = dpp_f<0x141>(bv); const int oj = dpp_i<0x141>(bj); if (ov > bv || (ov == bv && oj < bj)) { bv = ov; bj = oj; } }
        if (bv > -INFINITY && (bj >> 4) == sub) {
          m16 |= 1u << (bj & 15);
#pragma unroll
          for (int u = 0; u < 16; ++u) if ((bj & 15) == u) vals[u] = -INFINITY;
        }
      }
    }
    selm[(wv * 8 + qi2) * 8 + sub] = (unsigned short)m16;
    unsigned um = m16; um |= __shfl_xor(um, 8); um |= __shfl_xor(um, 16); um |= __shfl_xor(um, 32);
    if (lane < 8) atomicOr(&uni[sub], um);
  }
  __syncthreads();
  if (tid < 128) {
    const int wd = tid >> 4, bt = tid & 15;
    const unsigned uw = uni[wd];
    int pos = __popc(uw & ((1u << bt) - 1u));
    for (int i = 0; i < wd; ++i) pos += __popc(uni[i]);
    if ((uw >> bt) & 1u) tlist[pos] = (unsigned char)tid;
    if (tid == 127) *(int*)(tlist + 128) = pos + ((uw >> bt) & 1u);
  }
  __syncthreads();
  {
    const int nts = *(const int*)(tlist + 128);
    const uint4 mq = *(const uint4*)(selm + (wv * 8 + qi) * 8);
    float m = -INFINITY, l = 0.f;
#pragma unroll
    for (int db = 0; db < 2; ++db)
#pragma unroll
      for (int r = 0; r < 16; ++r) O[db][r] = 0.f;
    tile_loop(Kl, Vl, ksg, vsg, nts, tid, [&](int i) { return (size_t)tlist[nts - 1 - i] * 4096; }, [&](int it) {
      const int j = tlist[nts - 1 - it];
      const unsigned wsel = (j < 32) ? mq.x : (j < 64) ? mq.y : (j < 96) ? mq.z : mq.w;
      const bool sel = (wsel >> (j & 31)) & 1u;
      if (__ballot(sel) == 0ull) return;
      qk_tile(Kl, qf, Sx, lane);
      const float sbh = sel ? slope2 * (float)(64 * j + 4 * h - sq) : -INFINITY;
      if (j == cur) bias_mask<1>(Sx, slope2, ql - 4 * h, 0); else bias_mask<0>(Sx, slope2, 0, 0);
      online_update(Sx, O, m, l, sbh);
      pv_tile(Vl, Sx, O, lane);
    });
    l = xsum32(l);
    const float sc = gate_s / fmaxf(l, 1e-30f);
#pragma unroll
    for (int db = 0; db < 2; ++db)
#pragma unroll
      for (int r = 0; r < 16; r += 2) { const unsigned u = outl[256 * (db * 8 + (r >> 1))]; outl[256 * (db * 8 + (r >> 1))] = pk2(__uint_as_float(u << 16) + sc * O[db][r], __uint_as_float(u & 0xffff0000u) + sc * O[db][r + 1]); }
  }
  {
    const int j0 = max(0, cur - 8);
    float m = -INFINITY, l = 0.f;
#pragma unroll
    for (int db = 0; db < 2; ++db)
#pragma unroll
      for (int r = 0; r < 16; ++r) O[db][r] = 0.f;
    tile_loop(Kl, Vl, kwg, vwg, cur - j0 + 1, tid, [&](int i) { return (size_t)(cur - i) * 4096; }, [&](int it) {
      const int j = cur - it;
      qk_tile(Kl, qf, Sx, lane);
      const float sbh = slope2 * (float)(64 * j + 4 * h - sq);
      if (j == cur) bias_mask<1>(Sx, slope2, ql - 4 * h, 0);
      else if (j == cur - 8) bias_mask<2>(Sx, slope2, 0, ql - 4 * h);
      else bias_mask<0>(Sx, slope2, 0, 0);
      online_update(Sx, O, m, l, sbh);
      pv_tile(Vl, Sx, O, lane);
    });
    l = xsum32(l);
    const float sc = gate_w / fmaxf(l, 1e-30f);
#pragma unroll
    for (int db = 0; db < 2; ++db)
#pragma unroll
      for (int r = 0; r < 16; r += 2) { const unsigned u = outl[256 * (db * 8 + (r >> 1))]; O[db][r] = __uint_as_float(u << 16) + sc * O[db][r]; O[db][r + 1] = __uint_as_float(u & 0xffff0000u) + sc * O[db][r + 1]; }
  }
  {
    bf16* op = w.oa() + (size_t)t * 512 + hq * 64;
#pragma unroll
    for (int db = 0; db < 2; ++db)
#pragma unroll
      for (int a = 0; a < 4; ++a) {
        uint2 v; v.x = pk2(O[db][4 * a], O[db][4 * a + 1]); v.y = pk2(O[db][4 * a + 2], O[db][4 * a + 3]);
        *(uint2*)(op + db * 32 + 8 * a + 4 * h) = v;
      }
  }
  __syncthreads();
}

__device__ __forceinline__ void moba_store_part(const WS& w, const f32x16 (&O)[2], float m, float l, int t, int hd, int slot, bool valid, int lane) {
  const int h = lane >> 5;
  l = xsum32(l);
  const float sc = 1.f / fmaxf(l, 1e-30f);
  if (valid) {
    bf16* op = w.mbpart() + ((size_t)(t * 8 + hd) * 4 + slot) * 64;
#pragma unroll
    for (int db = 0; db < 2; ++db)
#pragma unroll
      for (int a = 0; a < 4; ++a) {
        uint2 v; v.x = pk2(sc * O[db][4 * a], sc * O[db][4 * a + 1]); v.y = pk2(sc * O[db][4 * a + 2], sc * O[db][4 * a + 3]);
        *(uint2*)(op + db * 32 + 8 * a + 4 * h) = v;
      }
    if (h == 0) w.mblse()[(size_t)(t * 8 + hd) * 4 + slot] = (l > 0.f) ? m + __builtin_amdgcn_logf(l) : -INFINITY;
  }
}
__device__ __forceinline__ void moba_gate_unit(const WS& w, unsigned char* lds, int unit, int shadow = 0) {
  int tid = threadIdx.x; asm volatile("" : "+v"(tid));
  const int lane = tid & 63, wv = tid >> 6, h = lane >> 5;
  unsigned char* Kl = lds; unsigned char* Vl = lds + KL_BYTES;
  const int bh = unit >> 6, c128 = unit & 63, hd = bh & 7;
  const int s0 = c128 * 128, cur = s0 >> 8;
  const int sq = s0 + wv * 32 + (lane & 31), t = (bh >> 3) * S + sq;
  const bf16* qg = w.qkvb() + (size_t)(0 * 16 + bh) * S * 64;
  bf16x8 qf[4];
#pragma unroll
  for (int ks = 0; ks < 4; ++ks) qf[ks] = *(const bf16x8*)(qg + (size_t)sq * 64 + ks * 16 + 8 * h);
  StageRegs sr;
  sr.k0 = sr.k1 = sr.v0 = sr.v1 = make_uint4(0, 0, 0, 0);
  f32x16 Sx[2];
  const bf16* km = w.kmb() + (size_t)bh * 4096;
  stage_load(km, km, sr, tid);
  __syncthreads(); stage_store(Kl, Vl, sr, tid); __syncthreads();
  qk_tile(Kl, qf, Sx, lane);
  float gv[16];
#pragma unroll
  for (int r = 0; r < 16; ++r) { const int n = (r & 3) + 8 * (r >> 2) + 4 * h; gv[r] = (n < cur) ? Sx[0][r] + Sx[1][r] : -INFINITY; }
  int* lcnt = (int*)(lds + KL_BYTES + VL_BYTES);
  if (tid < 64) lcnt[tid] = 0;
  __syncthreads();
  int pkn[3], pkp[3];
#pragma unroll
  for (int round = 0; round < 3; ++round) {
    float bv = gv[0]; int bn = 4 * h;
#pragma unroll
    for (int r = 1; r < 16; ++r) if (gv[r] > bv) { bv = gv[r]; bn = (r & 3) + 8 * (r >> 2) + 4 * h; }
    { const float ov = __shfl_xor(bv, 32); const int on = __shfl_xor(bn, 32); if (ov > bv || (ov == bv && on < bn)) { bv = ov; bn = on; } }
    const bool has = bv > -INFINITY;
    pkn[round] = has ? bn : -1; pkp[round] = 0;
    if (has) {
#pragma unroll
      for (int r = 0; r < 16; ++r) if (bn == (r & 3) + 8 * (r >> 2) + 4 * h) gv[r] = -INFINITY;
      if (h == 0) pkp[round] = atomicAdd(&lcnt[bn], 1);
    } else if (h == 0) (shadow ? (float*)(w.hid() + 8388608) : w.mblse())[(size_t)(t * 8 + hd) * 4 + round] = -INFINITY;
  }
  __syncthreads();
  if (tid < 32) { const int c = lcnt[tid]; lcnt[32 + tid] = c ? atomicAdd(&w.mbcnt()[shadow * 512 + bh * 32 + tid], c) : 0; }
  __syncthreads();
  if (h == 0) {
#pragma unroll
    for (int round = 0; round < 3; ++round)
      if (pkn[round] >= 0) (shadow ? (unsigned short*)w.hid() : w.mbql())[(size_t)(bh * 32 + pkn[round]) * 8192 + lcnt[32 + pkn[round]] + pkp[round]] = (unsigned short)((sq << 2) | round);
  }
  __syncthreads();
}
__device__ __forceinline__ void moba_own_unit(const WS& w, unsigned char* lds, int unit) {
  int tid = threadIdx.x; asm volatile("" : "+v"(tid));
  const int lane = tid & 63, wv = tid >> 6, h = lane >> 5;
  unsigned char* Kl = lds; unsigned char* Vl = lds + KL_BYTES;
  const int bh = unit >> 6, c128 = unit & 63, hd = bh & 7;
  const int s0 = c128 * 128, cur = s0 >> 8;
  const int sq = s0 + wv * 32 + (lane & 31), t = (bh >> 3) * S + sq;
  const bf16* qg = w.qkvb() + (size_t)(0 * 16 + bh) * S * 64;
  const bf16* kg = w.qkvb() + (size_t)(1 * 16 + bh) * S * 64;
  const bf16* vg = w.qkvb() + (size_t)(2 * 16 + bh) * S * 64;
  const float slope2 = slope_b(hd) * LOG2E;
  bf16x8 qf[4];
#pragma unroll
  for (int ks = 0; ks < 4; ++ks) qf[ks] = *(const bf16x8*)(qg + (size_t)sq * 64 + ks * 16 + 8 * h);
  StageRegs sr;
  sr.k0 = sr.k1 = sr.v0 = sr.v1 = make_uint4(0, 0, 0, 0);
  f32x16 Sx[2], O[2];
  float m = -INFINITY, l = 0.f;
#pragma unroll
  for (int db = 0; db < 2; ++db)
#pragma unroll
    for (int r = 0; r < 16; ++r) O[db][r] = 0.f;
  const int nown = 2 * ((s0 >> 7) & 1) + 2;
  tile_loop(Kl, Vl, kg, vg, nown, tid, [&](int i) { return (size_t)(cur * 256 + (nown - 1 - i) * 64) * 64; }, [&](int it) {
    const int tt = nown - 1 - it;
    const int pos0 = cur * 256 + tt * 64;
    if (pos0 > s0 + wv * 32 + 31) return;
    qk_tile(Kl, qf, Sx, lane);
    bias_mask<1>(Sx, slope2, sq - pos0 - 4 * h, 0);
    online_update(Sx, O, m, l, slope2 * (float)(pos0 + 4 * h - sq));
    pv_tile(Vl, Sx, O, lane);
  });
  moba_store_part(w, O, m, l, t, hd, 3, true, lane);
  __syncthreads();
}
__device__ __forceinline__ void moba_gath_unit(const WS& w, unsigned char* lds, int list, int chunk, int cnt) {
  int tid = threadIdx.x; asm volatile("" : "+v"(tid));
  const int lane = tid & 63, wv = tid >> 6, h = lane >> 5;
  unsigned char* Kl = lds; unsigned char* Vl = lds + KL_BYTES;
  const int bh = list >> 5, n = list & 31, hd = bh & 7;
  const int qidx = chunk * 128 + wv * 32 + (lane & 31);
  const bool valid = qidx < cnt;
  StageRegs ps0, ps1;
  { const bf16* kg0 = w.qkvb() + ((size_t)(1 * 16 + bh) * S + n * 256) * 64; const bf16* vg0 = w.qkvb() + ((size_t)(2 * 16 + bh) * S + n * 256) * 64;
    stage_load(kg0 + (size_t)(3 * 64) * 64, vg0 + (size_t)(3 * 64) * 64, ps0, tid); stage_load(kg0 + (size_t)(2 * 64) * 64, vg0 + (size_t)(2 * 64) * 64, ps1, tid); }
  const unsigned ent = w.mbql()[(size_t)list * 8192 + (valid ? qidx : 0)];
  const int sq = (int)(ent >> 2), slot = (int)(ent & 3u), t = (bh >> 3) * S + sq;
  const bf16* qg = w.qkvb() + (size_t)(0 * 16 + bh) * S * 64;
  const bf16* kg = w.qkvb() + ((size_t)(1 * 16 + bh) * S + n * 256) * 64;
  const bf16* vg = w.qkvb() + ((size_t)(2 * 16 + bh) * S + n * 256) * 64;
  const float slope2 = slope_b(hd) * LOG2E;
  bf16x8 qf[4];
#pragma unroll
  for (int ks = 0; ks < 4; ++ks) qf[ks] = *(const bf16x8*)(qg + (size_t)sq * 64 + ks * 16 + 8 * h);
  StageRegs sr;
  sr.k0 = sr.k1 = sr.v0 = sr.v1 = make_uint4(0, 0, 0, 0);
  f32x16 Sx[2], O[2];
  float m = -INFINITY, l = 0.f;
#pragma unroll
  for (int db = 0; db < 2; ++db)
#pragma unroll
    for (int r = 0; r < 16; ++r) O[db][r] = 0.f;
  tile_loop_pre(Kl, Vl, kg, vg, 4, tid, [&](int i) { return (size_t)((3 - i) * 64) * 64; }, [&](int it) {
    const int tt = 3 - it;
    qk_tile(Kl, qf, Sx, lane);
    bias_mask<0>(Sx, slope2, 0, 0);
    online_update(Sx, O, m, l, slope2 * (float)(n * 256 + tt * 64 + 4 * h - sq));
    pv_tile(Vl, Sx, O, lane);
  }, ps0, ps1);
  moba_store_part(w, O, m, l, t, hd, slot, valid, lane);
  __syncthreads();
}

#define XB_TMO      128
#define XB_XCNT(j)  (256  + 64 * (j))
#define XB_XSUB(j)  (1280 + 64 * (j))
#define XB_XGEN(j)  (2304 + 64 * (j))
#define XB_TOP      3328
#define XB_TOPGEN   3392
#define XCD_BAR_WORDS 3456
#define XB_SPIN_CAP (1u << 18)
__device__ __forceinline__ unsigned xb_ld(unsigned* p)              { return __hip_atomic_load(p, __ATOMIC_RELAXED, __HIP_MEMORY_SCOPE_AGENT); }
__device__ __forceinline__ unsigned xb_add(unsigned* p, unsigned v) { return __hip_atomic_fetch_add(p, v, __ATOMIC_RELAXED, __HIP_MEMORY_SCOPE_AGENT); }
__device__ __forceinline__ unsigned xb_xcc_id() { return (unsigned)__builtin_amdgcn_s_getreg((3 << 11) | 20) & 0xFu; }
#define XB_SPIN(cond, bar) do { unsigned _sp = 0; while (cond) { __builtin_amdgcn_s_sleep(1); \
    if ((++_sp & 255u) == 0u) { if (xb_ld(&(bar)[XB_TMO])) break; if (_sp > XB_SPIN_CAP) { atomicAdd(&(bar)[XB_TMO], 1u); break; } } } } while (0)
struct XcdBarrier { unsigned* bar; unsigned x; volatile LAS unsigned* st; };
__device__ __forceinline__ XcdBarrier xcd_barrier_post(unsigned* bar, volatile LAS unsigned* st) {
    XcdBarrier b; b.bar = bar; b.x = xb_xcc_id(); b.st = st;
    if (threadIdx.x == 0) (void)xb_add(&bar[XB_XCNT(b.x)], 1u);
    return b;
}
__device__ __forceinline__ void xcd_barrier_complete(unsigned* bar, unsigned x, unsigned& nloc, unsigned& nx) {
    const unsigned G = gridDim.x * gridDim.y * gridDim.z;
    unsigned sum, cnt, mine, sp = 0u;
    for (;;) {
        sum = 0u; cnt = 0u; mine = 0u;
#pragma unroll
        for (unsigned j = 0; j < 16; ++j) { const unsigned c = xb_ld(&bar[XB_XCNT(j)]); sum += c; cnt += (c > 0u) ? 1u : 0u; mine = (j == x) ? c : mine; }
        if (sum == G) break;
        __builtin_amdgcn_s_sleep(1);
        if ((++sp & 255u) == 0u) { if (xb_ld(&bar[XB_TMO])) break; if (sp > XB_SPIN_CAP) { atomicAdd(&bar[XB_TMO], 1u); break; } }
    }
    nloc = mine > 0u ? mine : 1u; nx = cnt > 0u ? cnt : 1u;
}
__device__ __forceinline__ void xcd_barrier(const XcdBarrier& b) {
    asm volatile("s_waitcnt vmcnt(0)" ::: "memory");
    __syncthreads();
    if (threadIdx.x == 0) {
        unsigned* bar = b.bar;
        __builtin_amdgcn_s_waitcnt(0);
        unsigned nloc = b.st[0], nx = b.st[1];
        if (nloc == 0u) { xcd_barrier_complete(bar, b.x, nloc, nx); b.st[0] = nloc; b.st[1] = nx; }
        const unsigned old = xb_add(&bar[XB_XSUB(b.x)], 1u);
        const unsigned gen = old / nloc;
        if (old + 1u == (gen + 1u) * nloc) {
            __builtin_amdgcn_fence(__ATOMIC_RELEASE, "agent");
            asm volatile("s_waitcnt vmcnt(0)" ::: "memory");
            const unsigned og = xb_add(&bar[XB_TOP], 1u);
            const unsigned tg = og / nx;
            if (og + 1u == (tg + 1u) * nx) xb_add(&bar[XB_TOPGEN], 1u);
            else XB_SPIN(xb_ld(&bar[XB_TOPGEN]) == tg, bar);
            __builtin_amdgcn_fence(__ATOMIC_ACQUIRE, "agent");
            xb_add(&bar[XB_XGEN(b.x)], 1u);
            asm volatile("s_waitcnt vmcnt(0)" ::: "memory");
        } else {
            XB_SPIN(xb_ld(&bar[XB_XGEN(b.x)]) == gen, bar);
            __builtin_amdgcn_fence(__ATOMIC_ACQUIRE, "agent");
            asm volatile("s_waitcnt vmcnt(0)" ::: "memory");
        }
    }
    __syncthreads();
}

__global__ void __launch_bounds__(NT, 2) fwd_megakernel(Params p) {
  cg::grid_group grid = cg::this_grid();
  constexpr int LDS_MAIN = ATT_LDS > GEMM_LDS ? ATT_LDS : GEMM_LDS;
  static_assert(GEMM2_LDS <= 65536 && LDS_MAIN >= 65536 + 1024, "LDS map");
  __shared__ __attribute__((aligned(16))) unsigned char lds_raw[LDS_MAIN + 16];
  float* lds = (float*)lds_raw;
  const WS w = make_ws(p.ws);
  const int bid = blockIdx.x, nblk = gridDim.x;
  volatile LAS unsigned* xst = (volatile LAS unsigned*)(LAS unsigned char*)(lds_raw + LDS_MAIN);
  if (threadIdx.x < 4) xst[threadIdx.x] = 0u;
  __syncthreads();
  const XcdBarrier xb = xcd_barrier_post((unsigned*)(p.ws + O_BAR), xst);
#define IDS() int tid = threadIdx.x; asm volatile("" : "+v"(tid)); const int lane = tid & 63; const int gtid = bid * NT + tid, gthreads = nblk * NT; const int gw = gtid >> 6, ngw = gthreads >> 6; (void)lane; (void)gw; (void)ngw; (void)gthreads;

  if (PHASES & (1u << 0)) for (int rep_ = 0; rep_ <= (int)((REPMASK >> 0) & 1u); ++rep_) {
  IDS();
  {
    for (int i = tid; i < 2048; i += NT) lds[i] = siluf_(p.c[i]);
    __syncthreads();
    for (int cb = bid; cb < 384; cb += nblk) {
      const int c = tid & 15, kg = tid >> 4;
      float a0 = 0.f, a1 = 0.f;
      const float* wp = p.w_ada + (size_t)(64 * kg) * 6144 + cb * 16 + c;
#pragma unroll 16
      for (int k = 0; k < 64; ++k) { const float wv_ = wp[(size_t)k * 6144]; a0 += lds[64 * kg + k] * wv_; a1 += lds[1024 + 64 * kg + k] * wv_; }
      lds[2048 + (kg * 2 + 0) * 16 + c] = a0; lds[2048 + (kg * 2 + 1) * 16 + c] = a1;
      __syncthreads();
      if (tid < 32) {
        const int b = tid >> 4;
        float a = p.b_ada[cb * 16 + c];
        for (int g = 0; g < 16; ++g) a += lds[2048 + (g * 2 + b) * 16 + c];
        w.ada()[b * 6144 + cb * 16 + c] = a;
      }
      __syncthreads();
    }
  }
  {
    auto cvt = [&](const float* src_, bf16* dst_, int n4) {
      for (int idx = gtid; idx < n4; idx += 4 * gthreads) {
        float4 v[4];
#pragma unroll
        for (int u = 0; u < 4; ++u) v[u] = ((const float4*)src_)[min(idx + u * gthreads, n4 - 1)];
#pragma unroll
        for (int u = 0; u < 4; ++u) if (idx + u * gthreads < n4) ((uint2*)dst_)[idx + u * gthreads] = to_bf16x4(v[u]);
      }
    };
    cvt(p.w_in, w.wb_in(), D * INC / 4);
  }
  for (int idx = gtid; idx < 256; idx += gthreads) w.counts()[idx] = 0;
  for (int idx = gtid; idx < 8; idx += gthreads) w.erb()[512 + idx] = 0;
  for (int idx = gtid; idx < 1024; idx += gthreads) w.mbcnt()[idx] = 0;
  for (int idx = gtid; idx < 8 * 64; idx += gthreads) w.kcb()[((size_t)(idx >> 6) * 512 + 511) * 64 + (idx & 63)] = 0;
  }
  xcd_barrier(xb);
#ifdef EXTRA_SYNCS
  for (int i_ = 0; i_ < EXTRA_SYNCS; ++i_) xcd_barrier(xb);
#endif
  if (PHASES & (1u << 2)) for (int rep_ = 0; rep_ <= (int)((REPMASK >> 2) & 1u); ++rep_) {
  IDS();
  for (int t = gw; t < T; t += ngw) {
    const float* ad = w.ada() + (t >> 13) * 6144;
    rms_mod_row(p.x + (size_t)t * D, p.norm1_g, ad + 1024, ad, w.h1b() + (size_t)t * D, lane);
  }
  }
  xcd_barrier(xb);
  if (PHASES & (1u << 3)) for (int rep_ = 0; rep_ <= (int)((REPMASK >> 3) & 1u); ++rep_) {
  IDS();
  {
    const int tn = (INC + 127) / 128, tm = T / 256;
    const int xg = bid & 7, nl = (tn - xg + 7) >> 3, nlb = (nblk - xg + 7) >> 3;
    for (int it = bid >> 3; it < tm * nl; it += nlb) {
      const int m0 = (it / nl) * 256, n0 = (xg + 8 * (it % nl)) * 128;
      f32x16 acc[4][2];
      gemm256_core(lds_raw, acc, m0, n0, T, INC, D,
        [&](int r) { return (const bf16*)(w.h1b() + (size_t)r * D); },
        [&](int k, int c) { return *(const uint2*)(w.wb_in() + (size_t)k * INC + c); });
      epi256_rows16(acc, lds_raw, m0, n0, T, INC,
        [&](int r, int c, float4 va, float4 vb) {
          const int b = r >> 13, s = r & (S - 1);
          if (c < 512) st_bf16x8(w.qa() + (size_t)r * 512 + c, scale4(va, 0.125f * LOG2E), scale4(vb, 0.125f * LOG2E));
          else if (c < 1280) { const int cc = c - 512, i = cc >> 7, h = (cc >> 6) & 1, d = cc & 63; st_bf16x8(w.kva() + ((size_t)((i * 2 + b) * 2 + h) * S + s) * 64 + d, va, vb); }
          else if (c < 1304) { float* gp = w.ga() + (size_t)r * 24 + (c - 1280); *(float4*)gp = sig4(va); *(float4*)(gp + 4) = sig4(vb); }
          else if (c < 2840) { const int cc = c - 1304, i = cc >> 9, h = (cc >> 6) & 7, d = cc & 63;
            st_bf16x8(w.qkvb() + ((size_t)((i * 2 + b) * 8 + h) * S + s) * 64 + d, i == 0 ? scale4(va, 0.125f * LOG2E) : va, i == 0 ? scale4(vb, 0.125f * LOG2E) : vb); }
          else st_bf16x8(w.gab() + (size_t)r * 2048 + (c - 2840), sig4(va), sig4(vb));
        });
    }
    if (xg == ((nblk >= 8) ? 7 : nblk - 1)) {
      const int pb = bid >> 3;
      auto cvt2 = [&](const float* src_, bf16* dst_, int n4) {
        for (int idx = pb * NT + tid; idx < n4; idx += 4 * nlb * NT) {
          float4 v[4];
#pragma unroll
          for (int u = 0; u < 4; ++u) v[u] = ((const float4*)src_)[min(idx + u * nlb * NT, n4 - 1)];
#pragma unroll
          for (int u = 0; u < 4; ++u) if (idx + u * nlb * NT < n4) ((uint2*)dst_)[idx + u * nlb * NT] = to_bf16x4(v[u]);
        }
      };
      cvt2(p.w_up_a, w.wb_upa(), 512 * D / 4); cvt2(p.w_up_b, w.wb_upb(), 512 * D / 4); cvt2(p.w_out, w.wb_out(), D * D / 4); cvt2(p.w_s_down, w.wb_sd(), 256 * D / 4);
    for (int idx = pb * NT + tid; idx < 2 * 3 * 1024 * 64; idx += nlb * NT) {
      const int n4 = idx & 63, k = (idx >> 6) & 1023, bw = idx >> 16, wh = bw % 3, b = bw / 3;
      const float* ws_ = wh == 0 ? p.w_router : wh == 1 ? p.w_s_gate : p.w_s_up;
      const float4 wv = *(const float4*)(ws_ + (size_t)k * 256 + 4 * n4);
      const float G = p.norm2_g[k] * (1.f + w.ada()[b * 6144 + 4096 + k]);
      st_bf16x4(w.w2f() + ((size_t)bw * 1024 + k) * 256 + 4 * n4, make_float4(G * wv.x, G * wv.y, G * wv.z, G * wv.w));
    }
    for (int item = pb; item < 96; item += nlb) {
      const int b = item / 48, nb = item % 48, c = tid & 15, kg = tid >> 4, n = nb * 16 + c, wh = n >> 8, nn = n & 255;
      const float* ws_ = wh == 0 ? p.w_router : wh == 1 ? p.w_s_gate : p.w_s_up;
      const float* sh_ = w.ada() + b * 6144 + 3072;
      float a = 0.f;
#pragma unroll 16
      for (int k = 64 * kg; k < 64 * kg + 64; ++k) a += sh_[k] * ws_[(size_t)k * 256 + nn];
      __syncthreads();
      lds[kg * 16 + c] = a;
      __syncthreads();
      if (tid < 16) { float s = 0.f; for (int g = 0; g < 16; ++g) s += lds[g * 16 + tid]; w.c2()[b * 768 + nb * 16 + tid] = s; }
    }
  }
  }
  }
  xcd_barrier(xb);
  if (PHASES & (1u << 4)) for (int rep_ = 0; rep_ <= (int)((REPMASK >> 4) & 1u); ++rep_) {
  IDS();
  {
    for (int item = bid; item < 512; item += nblk) {
      const int ks = item & 7, nt = (item >> 3) & 1, mt = (item >> 4) & 15, which = item >> 8;
      const int m0 = mt * 128, n0 = nt * 128, koff = ks * 256;
      const float* pe = which ? p.pe_v : p.pe_k; const float* w1 = which ? p.w1_v : p.w1_k;
      float* part = w.tmpf() + (size_t)(ks * 2 + which) * 2044 * 256;
      gemm_tile_bf16(lds_raw, m0, n0, 2044, 256, 256,
        [&](int r, int kk) {
          const int k = kk + koff;
          const int bh = r / NC, i = r % NC, b = bh >> 1, h = bh & 1, j = k >> 6, d = k & 63;
          const uint4 u = *(const uint4*)(w.kva() + ((size_t)((which * 2 + b) * 2 + h) * S + 16 * i + j) * 64 + d);
          const float* ep = pe + j * 64 + d;
          const float4 e0 = *(const float4*)ep, e1 = *(const float4*)(ep + 4);
          return pack8(make_float4(__uint_as_float(u.x << 16) + e0.x, __uint_as_float(u.x & 0xffff0000u) + e0.y, __uint_as_float(u.y << 16) + e0.z, __uint_as_float(u.y & 0xffff0000u) + e0.w),
                       make_float4(__uint_as_float(u.z << 16) + e1.x, __uint_as_float(u.z & 0xffff0000u) + e1.y, __uint_as_float(u.w << 16) + e1.z, __uint_as_float(u.w & 0xffff0000u) + e1.w));
        },
        [&](int kk, int c) { return *(const float4*)(w1 + (size_t)(kk + koff) * 256 + c); },
        [&](int r, int c, float4 v) { *(float4*)(part + (size_t)r * 256 + c) = v; });
    }
    for (int item = bid; item < 512; item += nblk) {
      const int bh = item >> 5, n = item & 31, rg = tid >> 3, c8 = tid & 7;
      const bf16* kb = w.qkvb() + ((size_t)(16 + bh) * S + 256 * n) * 64 + c8 * 8;
      float a8[8];
#pragma unroll
      for (int e = 0; e < 8; ++e) a8[e] = 0.f;
#pragma unroll
      for (int i = 0; i < 8; ++i) {
        const uint4 u = *(const uint4*)(kb + (size_t)(rg + 32 * i) * 64);
        a8[0] += __uint_as_float(u.x << 16); a8[1] += __uint_as_float(u.x & 0xffff0000u); a8[2] += __uint_as_float(u.y << 16); a8[3] += __uint_as_float(u.y & 0xffff0000u);
        a8[4] += __uint_as_float(u.z << 16); a8[5] += __uint_as_float(u.z & 0xffff0000u); a8[6] += __uint_as_float(u.w << 16); a8[7] += __uint_as_float(u.w & 0xffff0000u);
      }
      __syncthreads();
#pragma unroll
      for (int e = 0; e < 8; ++e) lds[rg * 64 + c8 * 8 + e] = a8[e];
      __syncthreads();
      if (tid < 64) {
        float s = 0.f;
        for (int r = 0; r < 32; ++r) s += lds[r * 64 + tid];
        const float mean = s * (1.f / 256.f); const bf16 hi = f2bf(mean);
        w.kmb()[((size_t)bh * 64 + n) * 64 + tid] = hi; w.kmb()[((size_t)bh * 64 + 32 + n) * 64 + tid] = f2bf(mean - bf2f(hi));
      }
      __syncthreads();
    }
  }
  }
  xcd_barrier(xb);
  if (PHASES & (1u << 5)) for (int rep_ = 0; rep_ <= (int)((REPMASK >> 5) & 1u); ++rep_) {
  IDS();
  {
    const int tm = 16;
    for (int tile = bid; tile < 2 * tm; tile += nblk) {
      const int which = tile / tm, m0 = (tile % tm) * 128;
      const float* w2 = which ? p.w2_v : p.w2_k;
      gemm_tile_bf16(lds_raw, m0, 0, 2044, 64, 256,
        [&](int r, int k) {
          const float* b1 = which ? p.b1_v : p.b1_k;
          float4 s0 = *(const float4*)(b1 + k), s1 = *(const float4*)(b1 + k + 4);
#pragma unroll
          for (int ks = 0; ks < 8; ++ks) {
            const float* pp = w.tmpf() + ((size_t)(ks * 2 + which) * 2044 + r) * 256 + k;
            const float4 a0 = *(const float4*)pp, a1 = *(const float4*)(pp + 4);
            s0.x += a0.x; s0.y += a0.y; s0.z += a0.z; s0.w += a0.w; s1.x += a1.x; s1.y += a1.y; s1.z += a1.z; s1.w += a1.w;
          }
          return pack8(make_float4(gelu_tanh(s0.x), gelu_tanh(s0.y), gelu_tanh(s0.z), gelu_tanh(s0.w)), make_float4(gelu_tanh(s1.x), gelu_tanh(s1.y), gelu_tanh(s1.z), gelu_tanh(s1.w)));
        },
        [&](int k, int c) { return *(const float4*)(w2 + (size_t)k * 64 + c); },
        [&](int r, int c, float4 v) { const int bh = r / NC, i = r % NC; st_bf16x4(w.kcb() + ((size_t)(which * 4 + bh) * 512 + i) * 64 + c, v); });
    }
    for (int u = (bid + nblk / 2) % nblk; u < 1024; u += nblk) moba_gate_unit(w, lds_raw, u, rep_);
    __syncthreads();
  }
  }
  xcd_barrier(xb);
  if (PHASES & (1u << 6)) for (int rep_ = 0; rep_ <= (int)((REPMASK >> 6) & 1u); ++rep_) {
  IDS();
  {
#ifndef NO_NSA
    const int vb = (nblk & 7) ? bid : ((bid & 7) * (nblk >> 3) + (bid >> 3));
    for (int u = vb; u < 1024; u += nblk) nsa_unit(w, lds_raw, u);
#endif
    __syncthreads();
#ifndef NO_MOBA
    {
      int* cum = (int*)(lds_raw + 20480);
      __syncthreads();
      for (int i = tid; i < 512; i += NT) cum[1 + i] = (w.mbcnt()[i] + 127) >> 7;
      __syncthreads();
      if (tid < 64) {
        int v[8]; int s = 0;
#pragma unroll
        for (int e = 0; e < 8; ++e) { s += cum[1 + tid * 8 + e]; v[e] = s; }
        int incl = s;
#pragma unroll
        for (int o = 1; o < 64; o <<= 1) { const int y = __shfl_up(incl, o); if (tid >= o) incl += y; }
        const int excl = incl - s;
#pragma unroll
        for (int e = 0; e < 8; ++e) cum[1 + tid * 8 + e] = excl + v[e];
        if (tid == 0) cum[0] = 0;
      }
      __syncthreads();
      const int ngath = cum[512];
      for (int u = vb; u < ngath + 1024; u += nblk) {
        if (u < ngath) {
          int lo = 0, hi = 512;
          while (hi - lo > 1) { const int mid = (lo + hi) >> 1; if (cum[mid] <= u) lo = mid; else hi = mid; }
          moba_gath_unit(w, lds_raw, lo, u - cum[lo], w.mbcnt()[lo]);
        } else moba_own_unit(w, lds_raw, u - ngath);
      }
    }
#endif
    __syncthreads();
  }
  }
  xcd_barrier(xb);
  if (PHASES & (1u << 7)) for (int rep_ = 0; rep_ <= (int)((REPMASK >> 7) & 1u); ++rep_) {
  IDS();
  {
    const bool merge_first = bid >= (nblk >> 1);
    for (int part = 0; part < 2; ++part) {
    if ((part == 0) != merge_first)
    for (int it = bid >> 3; it < 64; it += (nblk - (bid & 7) + 7) >> 3) {
      const int m0 = ((bid & 7) + 8 * (it >> 3)) * 256, n0 = (it & 7) * 128;
      gemm256_tile_pre(lds_raw, m0, n0, T, D, 512,
        [&](int r) { return (const bf16*)(w.oa() + (size_t)r * 512); },
        [&](int k, int c) { return *(const uint2*)(w.wb_upa() + (size_t)k * D + c); },
        [&](int r, int c) { const uint2 g = *(const uint2*)(w.gab() + (size_t)r * 2048 + c); return make_uint4(g.x, g.y, 0u, 0u); },
        [&](int r, int c, float4 v, uint4 pv) { st_bf16x4((bf16*)w.tmpf() + (size_t)r * D + c, mul4(v, up_bf16x4(pv.x, pv.y))); });
    }
    else
    for (int t = gw; t < T; t += ngw) {
      const int hd = lane >> 3, d8 = lane & 7;
      const float4 ls = *(const float4*)(w.mblse() + (size_t)(t * 8 + hd) * 4);
      const float mx = fmaxf(fmaxf(ls.x, ls.y), fmaxf(ls.z, ls.w));
      const float wgt[4] = {__builtin_amdgcn_exp2f(ls.x - mx), __builtin_amdgcn_exp2f(ls.y - mx), __builtin_amdgcn_exp2f(ls.z - mx), __builtin_amdgcn_exp2f(ls.w - mx)};
      const float inv = 1.f / (wgt[0] + wgt[1] + wgt[2] + wgt[3]);
      float a8[8];
#pragma unroll
      for (int e = 0; e < 8; ++e) a8[e] = 0.f;
      const bf16* pp = w.mbpart() + ((size_t)(t * 8 + hd) * 4) * 64 + d8 * 8;
#pragma unroll
      for (int i = 0; i < 4; ++i) {
        const uint4 u = *(const uint4*)(pp + i * 64);
        const float wi = wgt[i] * inv;
        if (wgt[i] > 0.f) {
          a8[0] += wi * __uint_as_float(u.x << 16); a8[1] += wi * __uint_as_float(u.x & 0xffff0000u); a8[2] += wi * __uint_as_float(u.y << 16); a8[3] += wi * __uint_as_float(u.y & 0xffff0000u);
          a8[4] += wi * __uint_as_float(u.z << 16); a8[5] += wi * __uint_as_float(u.z & 0xffff0000u); a8[6] += wi * __uint_as_float(u.w << 16); a8[7] += wi * __uint_as_float(u.w & 0xffff0000u);
        }
      }
      uint4 o; o.x = pk2(a8[0], a8[1]); o.y = pk2(a8[2], a8[3]); o.z = pk2(a8[4], a8[5]); o.w = pk2(a8[6], a8[7]);
      *(uint4*)(w.ob() + (size_t)t * 512 + hd * 64 + d8 * 8) = o;
    }
    }
    xcd_barrier(xb);
    for (int it = bid >> 3; it < 64; it += (nblk - (bid & 7) + 7) >> 3) {
      const int m0 = ((bid & 7) + 8 * (it >> 3)) * 256, n0 = (it & 7) * 128;
      gemm256_tile_pre(lds_raw, m0, n0, T, D, 512,
        [&](int r) { return (const bf16*)(w.ob() + (size_t)r * 512); },
        [&](int k, int c) { return *(const uint2*)(w.wb_upb() + (size_t)k * D + c); },
        [&](int r, int c) { const uint2 t2 = *(const uint2*)((const bf16*)w.tmpf() + (size_t)r * D + c), g2 = *(const uint2*)(w.gab() + (size_t)r * 2048 + 1024 + c); return make_uint4(t2.x, t2.y, g2.x, g2.y); },
        [&](int r, int c, float4 v, uint4 pv) { const float4 t4 = up_bf16x4(pv.x, pv.y), g4 = up_bf16x4(pv.z, pv.w);
          st_bf16x4(w.mrg() + (size_t)r * D + c, make_float4(t4.x + g4.x * v.x, t4.y + g4.y * v.y, t4.z + g4.z * v.z, t4.w + g4.w * v.w)); });
    }
  }
  }
  xcd_barrier(xb);
  if (PHASES & (1u << 8)) for (int rep_ = 0; rep_ <= (int)((REPMASK >> 8) & 1u); ++rep_) {
  IDS();
  {
    for (int it = bid >> 3; it < 64; it += (nblk - (bid & 7) + 7) >> 3) {
      const int m0 = ((bid & 7) + 8 * (it >> 3)) * 256, n0 = (it & 7) * 128;
      gemm256_tile_pre(lds_raw, m0, n0, T, D, D,
        [&](int r) { return (const bf16*)(w.mrg() + (size_t)r * D); },
        [&](int k, int c) { return *(const uint2*)(w.wb_out() + (size_t)k * D + c); },
        [&](int r, int c) { return *(const uint4*)(p.x + (size_t)r * D + c); },
        [&](int r, int c, float4 v, uint4 pv) { const float4 x4 = make_float4(__uint_as_float(pv.x), __uint_as_float(pv.y), __uint_as_float(pv.z), __uint_as_float(pv.w)), g4 = *(const float4*)(w.ada() + (r >> 13) * 6144 + 2048 + c);
          uint2 u; u.x = pk2(x4.x + g4.x * v.x, x4.y + g4.y * v.y); u.y = pk2(x4.z + g4.z * v.z, x4.w + g4.w * v.w);
          *(uint2*)((bf16*)w.x1() + (size_t)r * D + c) = u;
          const float e0 = __uint_as_float(u.x << 16), e1 = __uint_as_float(u.x & 0xffff0000u), e2 = __uint_as_float(u.y << 16), e3 = __uint_as_float(u.y & 0xffff0000u);
          float sq = e0 * e0 + e1 * e1 + e2 * e2 + e3 * e3;
          sq += dpp_f<0xB1>(sq); sq += dpp_f<0x4E>(sq); sq += dpp_f<0x141>(sq); sq += dpp_f<0x140>(sq);
          if ((c & 63) == 0) w.sqp()[(size_t)r * 16 + (c >> 6)] = sq; });
    }
  }
  }
  xcd_barrier(xb);
  if (PHASES & (1u << 10)) for (int rep_ = 0; rep_ <= (int)((REPMASK >> 10) & 1u); ++rep_) {
  IDS();
  {
    float* rsl = (float*)(lds_raw + 65536 + 1024);
    for (int it = bid >> 3; it < 48; it += (nblk - (bid & 7) + 7) >> 3) {
      const int pm = (bid & 7) + 8 * (it / 6), sub = it % 6, m0 = pm * 256, b = m0 >> 13;
      __syncthreads();
      { const float4* pp = (const float4*)(w.sqp() + (size_t)(m0 + tid) * 16);
        const float4 s0 = pp[0], s1 = pp[1], s2 = pp[2], s3 = pp[3];
        const float ss = ((s0.x + s0.y) + (s0.z + s0.w)) + ((s1.x + s1.y) + (s1.z + s1.w)) + ((s2.x + s2.y) + (s2.z + s2.w)) + ((s3.x + s3.y) + (s3.z + s3.w));
        rsl[tid] = rsqrtf(ss * (1.f / D) + 1e-6f); }
      const bf16* wf = w.w2f() + (size_t)b * 3 * 1024 * 256;
      const float* cb = w.c2() + b * 768;
      if (sub < 2) {
        const int n0 = sub * 128;
        gemm256_tile(lds_raw, m0, n0, T, 256, D,
          [&](int r) { return (const bf16*)w.x1() + (size_t)r * D; },
          [&](int k, int c) { return *(const uint2*)(wf + (size_t)k * 256 + c); },
          [&](int r, int c, float4 v) { const float rs = rsl[r - m0]; const float4 c4 = *(const float4*)(cb + c);
            *(float4*)(w.logits() + (size_t)r * 256 + c) = make_float4(rs * v.x + c4.x, rs * v.y + c4.y, rs * v.z + c4.z, rs * v.w + c4.w); });
      } else {
        const int h0 = (sub - 2) * 64;
        f32x16 acc[4][2];
        gemm256_core(lds_raw, acc, m0, 0, T, 128, D,
          [&](int r) { return (const bf16*)w.x1() + (size_t)r * D; },
          [&](int k, int c) { const bf16* wp = wf + (size_t)(((c >> 5) & 1) ? 2 : 1) * 1024 * 256; return *(const uint2*)(wp + (size_t)k * 256 + h0 + (c >> 6) * 32 + (c & 31)); });
        epi256_pair_rows(acc, lds_raw, m0, h0, T, [&](int r, int hc, float4 g, float4 u) {
          const float rs = rsl[r - m0]; const float4 cg = *(const float4*)(cb + 256 + hc), cu = *(const float4*)(cb + 512 + hc);
          const float4 gg = make_float4(rs * g.x + cg.x, rs * g.y + cg.y, rs * g.z + cg.z, rs * g.w + cg.w), uu = make_float4(rs * u.x + cu.x, rs * u.y + cu.y, rs * u.z + cu.z, rs * u.w + cu.w);
          st_bf16x4(w.shid() + (size_t)r * 256 + hc, make_float4(siluf_(gg.x) * uu.x, siluf_(gg.y) * uu.y, siluf_(gg.z) * uu.z, siluf_(gg.w) * uu.w)); });
      }
    }
    {
      const int nidle = nblk > 384 ? nblk - 384 : 0;
      const int w0 = nidle ? (bid - 384) * 4 + (tid >> 6) : gw, wn = nidle ? nidle * 4 : ngw;
      if (nidle == 0 || bid >= 384)
        for (int t = w0; t < T; t += 4 * wn) {
          float4 v[4][4];
#pragma unroll
          for (int rr = 0; rr < 4; ++rr) {
            const uint2* xr = (const uint2*)((const bf16*)w.x1() + (size_t)min(t + rr * wn, T - 1) * D);
#pragma unroll
            for (int j = 0; j < 4; ++j) v[rr][j] = bf4_to_f4(xr[lane + 64 * j]);
          }
#pragma unroll
          for (int rr = 0; rr < 4; ++rr) {
            const int tr = t + rr * wn;
            if (tr < T) {
              const float* ad = w.ada() + (tr >> 13) * 6144;
              rms_mod_row_t([&](int i) { return v[rr][i >> 6]; }, p.norm2_g, ad + 4096, ad + 3072, w.h1b() + (size_t)tr * D, lane);
            }
          }
        }
    }
  }
  }
  xcd_barrier(xb);
  if (PHASES & (1u << 11)) for (int rep_ = 0; rep_ <= (int)((REPMASK >> 11) & 1u); ++rep_) {
  IDS();
  {
    float4 lgn = *(const float4*)(w.logits() + (size_t)min(gw, T - 1) * 256 + 4 * lane);
    const bool tile_first = bid >= (nblk >> 1);
    for (int part = 0; part < 2; ++part) {
    if ((part == 0) != tile_first) {
    int pe_ = 0, ppos_ = 0, ptk_ = -1;
    if (rep_ == 0) for (int t = gw; t < T; t += ngw) {
      const float4 lg = lgn;
      lgn = *(const float4*)(w.logits() + (size_t)min(t + ngw, T - 1) * 256 + 4 * lane);
      const float4 bi = *(const float4*)(p.router_bias + 4 * lane);
      float sv[4] = {sigmoidf_(lg.x), sigmoidf_(lg.y), sigmoidf_(lg.z), sigmoidf_(lg.w)};
      float sb[4] = {sv[0] + bi.x, sv[1] + bi.y, sv[2] + bi.z, sv[3] + bi.w};
      float m1 = -INFINITY, m2 = -INFINITY;
#pragma unroll
      for (int r = 0; r < 4; ++r) { if (sb[r] > m1) { m2 = m1; m1 = sb[r]; } else if (sb[r] > m2) m2 = sb[r]; }
#define TOP2_MERGE(C) { const float o1 = dpp_f<C>(m1), o2 = dpp_f<C>(m2); const float n1 = fmaxf(m1, o1), n2 = fmaxf(fminf(m1, o1), fmaxf(m2, o2)); m1 = n1; m2 = n2; }
      TOP2_MERGE(0xB1) TOP2_MERGE(0x4E) TOP2_MERGE(0x141)
#undef TOP2_MERGE
      const float gs = m1 + m2;
      unsigned gsel = 0;
#pragma unroll
      for (int it = 0; it < 4; ++it) {
        float bv = ((gsel >> (lane >> 3)) & 1u) ? -INFINITY : gs; int bi_ = lane >> 3;
        wave_argmax(bv, bi_);
        gsel |= 1u << bi_;
      }
      const bool gok = (gsel >> (lane >> 3)) & 1u;
      float cnd[4];
#pragma unroll
      for (int r = 0; r < 4; ++r) cnd[r] = gok ? sb[r] : -INFINITY;
      float my_s = 0.f; int my_e = 0; float ssum = 0.f;
#pragma unroll
      for (int it = 0; it < 8; ++it) {
        float bv = cnd[0]; int be = 4 * lane; float bs = sv[0];
#pragma unroll
        for (int r = 1; r < 4; ++r) if (cnd[r] > bv) { bv = cnd[r]; be = 4 * lane + r; bs = sv[r]; }
        wave_argmax3(bv, be, bs);
#pragma unroll
        for (int r = 0; r < 4; ++r) if (be == 4 * lane + r) cnd[r] = -INFINITY;
        ssum += bs;
        if (lane == it) { my_s = bs; my_e = be; }
      }
      if (lane < 8) {
        w.eidx()[t * 8 + lane] = my_e; w.wts()[t * 8 + lane] = my_s / ssum * 2.5f;
        if (ptk_ >= 0) w.etok()[(size_t)pe_ * T + ppos_] = ptk_;
        ppos_ = atomicAdd(&w.counts()[my_e], 1); pe_ = my_e; ptk_ = t * 8 + lane;
      }
    }
    if (rep_ == 0 && lane < 8 && ptk_ >= 0) w.etok()[(size_t)pe_ * T + ppos_] = ptk_;
    } else
    for (int it = bid >> 3; it < 64; it += (nblk - (bid & 7) + 7) >> 3) {
      const int m0 = ((bid & 7) + 8 * (it >> 3)) * 256, n0 = (it & 7) * 128;
      gemm256_tile(lds_raw, m0, n0, T, D, 256,
        [&](int r) { return (const bf16*)(w.shid() + (size_t)r * 256); },
        [&](int k, int c) { return *(const uint2*)(w.wb_sd() + (size_t)k * D + c); },
        [&](int r, int c, float4 v) { st_bf16x4((bf16*)w.y() + (size_t)r * D + c, v); });
    }
    }
  }
  }
  xcd_barrier(xb);
#define EXPERT_LAYOUT() { int* sci = (int*)lds_raw; __syncthreads(); \
    const int cnt_ = w.counts()[tid]; const int pad_ = (cnt_ + 127) >> 7; \
    int inc_ = pad_;                                              \
    _Pragma("unroll") for (int o_ = 1; o_ < 64; o_ <<= 1) { const int y_ = __shfl_up(inc_, o_); if (lane >= o_) inc_ += y_; } \
    if (lane == 63) sci[tid >> 6] = inc_; \
    __syncthreads(); \
    int ps_ = inc_ - pad_; for (int w_ = 0; w_ < (tid >> 6); ++w_) ps_ += sci[w_]; \
    if ((tid & 7) == xg) { xe[3 * (tid >> 3)] = ps_; xe[3 * (tid >> 3) + 1] = pad_; xe[3 * (tid >> 3) + 2] = cnt_; } \
    __syncthreads(); \
    if (tid < 32) { const int v_ = (xe[3 * tid + 1] + 1) >> 1; int i2_ = v_; \
      _Pragma("unroll") for (int o_ = 1; o_ < 32; o_ <<= 1) { const int y_ = __shfl_up(i2_, o_); if (tid >= o_) i2_ += y_; } \
      cum[tid] = i2_ - v_; if (tid == 31) cum[32] = i2_; } \
    __syncthreads(); }
  if (PHASES & (1u << 13)) for (int rep_ = 0; rep_ <= (int)((REPMASK >> 13) & 1u); ++rep_) {
  IDS();
  {
    int* cum = (int*)(lds_raw + 65536);
    int* xe = cum + 64;
    const int xg = bid & 7, nlb = (nblk - xg + 7) >> 3;
    EXPERT_LAYOUT();
    const int ntile = cum[32] * 4;
    int i = 0;
    for (int t = bid >> 3; t < ntile; t += nlb) {
      while (i < 31 && 4 * cum[i + 1] <= t) ++i;
      const int e = xg + 8 * i, nte = cum[i + 1] - cum[i], loc = t - 4 * cum[i];
      const int h0 = (loc / nte) * 64, m0 = (xe[3 * i] + 2 * (loc % nte)) * 128, mend = (xe[3 * i] + xe[3 * i + 1]) * 128;
      const int pst = xe[3 * i] * 128, ecnt = xe[3 * i + 2];
      const int* etk = w.etok() + (size_t)e * T;
      auto rtok = [&](int r) { const int lr = r - pst; const int v = etk[min(lr, T - 1)]; return lr < ecnt ? v : -1; };
      const float* wg = p.w_e_gate + (size_t)e * D * 256; const float* wu = p.w_e_up + (size_t)e * D * 256;
      auto bl = [&](int k, int c) { const float* wp = ((c >> 5) & 1) ? wu : wg; return *(const float4*)(wp + (size_t)k * 256 + h0 + (c >> 6) * 32 + (c & 31)); };
      auto ep = [&](int r, int hc, float4 g, float4 u) { st_bf16x4(w.hid() + (size_t)r * 256 + hc, make_float4(siluf_(g.x) * u.x, siluf_(g.y) * u.y, siluf_(g.z) * u.z, siluf_(g.w) * u.w)); };
      if (m0 + 128 >= mend) {
        f32x16 acc[2][2];
        gemm_core(lds_raw, acc, m0, 0, mend, 128, D,
          [&](int r, int k) { const int pr = rtok(r); return *(const uint4*)(w.h1b() + (size_t)(pr >= 0 ? (pr >> 3) : 0) * D + k); }, bl);
        epi_pair_rows(acc, lds_raw, m0, h0, mend, ep);
      } else {
        f32x16 acc[4][2];
        gemm256_core(lds_raw, acc, m0, 0, mend, 128, D,
          [&](int r) { const int pr = rtok(r); return (const bf16*)(w.h1b() + (size_t)(pr >= 0 ? (pr >> 3) : 0) * D); }, bl);
        epi256_pair_rows(acc, lds_raw, m0, h0, mend, ep);
      }
    }
  }
  }
  xcd_barrier(xb);
  if (PHASES & (1u << 14)) for (int rep_ = 0; rep_ <= (int)((REPMASK >> 14) & 1u); ++rep_) {
  IDS();
  {
    int* cum = (int*)(lds_raw + 65536);
    int* xe = cum + 64;
    const int xg = bid & 7, nlb = (nblk - xg + 7) >> 3;
    EXPERT_LAYOUT();
    const int ntile = cum[32] * 8;
    int i = 0;
    for (int t = bid >> 3; t < ntile; t += nlb) {
      while (i < 31 && 8 * cum[i + 1] <= t) ++i;
      const int e = xg + 8 * i, nte = cum[i + 1] - cum[i], loc = t - 8 * cum[i];
      const int n0 = (loc / nte) * 128, m0 = (xe[3 * i] + 2 * (loc % nte)) * 128, mend = (xe[3 * i] + xe[3 * i + 1]) * 128;
      const int pst = xe[3 * i] * 128, ecnt = xe[3 * i + 2];
      const int* etk = w.etok() + (size_t)e * T;
      auto rtok = [&](int r) { const int lr = r - pst; const int v = etk[min(lr, T - 1)]; return lr < ecnt ? v : -1; };
      const float* wd = p.w_e_down + (size_t)e * 256 * D;
      auto bl = [&](int k, int c) { return *(const float4*)(wd + (size_t)k * D + c); };
      auto ep = [&](int r, int c, float4 v) { const int pr = rtok(r); if (pr >= 0) st_bf16x4(w.ye() + (size_t)pr * D + c, v); };
      if (m0 + 128 >= mend) gemm_tile_bf16(lds_raw, m0, n0, mend, D, 256, [&](int r, int k) { return *(const uint4*)(w.hid() + (size_t)r * 256 + k); }, bl, ep);
      else {
        int* tokl = (int*)(lds_raw + 65536 + 1024);
        __syncthreads();
        tokl[tid] = rtok(min(m0 + tid, mend - 1));
        f32x16 acc[4][2];
        gemm256_core(lds_raw, acc, m0, n0, mend, D, 256, [&](int r) { return (const bf16*)(w.hid() + (size_t)r * 256); }, bl);
        epi256_rows16(acc, lds_raw, m0, n0, mend, D,
          [&](int r, int c, float4 a, float4 b) { const int pr = tokl[r - m0]; if (pr >= 0) st_bf16x8(w.ye() + (size_t)pr * D + c, a, b); });
      }
    }
  }
  }
  xcd_barrier(xb);
  if (PHASES & (1u << 15)) for (int rep_ = 0; rep_ <= (int)((REPMASK >> 15) & 1u); ++rep_) {
  IDS();
  for (int t = gw; t < T; t += ngw) {
    const float* g2 = w.ada() + (t >> 13) * 6144 + 5120;
    float4 v[4]; float s = 0.f;
#pragma unroll
    for (int j = 0; j < 4; ++j) {
      const float4 a = bf4_to_f4(((const uint2*)((const bf16*)w.x1() + (size_t)t * D))[lane + 64 * j]), gg = ((const float4*)g2)[lane + 64 * j];
      float4 yy = bf4_to_f4(((const uint2*)((const bf16*)w.y() + (size_t)t * D))[lane + 64 * j]);
#pragma unroll
      for (int k = 0; k < 8; ++k) {
        const float wk = w.wts()[t * 8 + k];
        const uint2 e = ((const uint2*)(w.ye() + (size_t)(t * 8 + k) * D))[lane + 64 * j];
        yy.x += wk * __uint_as_float(e.x << 16); yy.y += wk * __uint_as_float(e.x & 0xffff0000u); yy.z += wk * __uint_as_float(e.y << 16); yy.w += wk * __uint_as_float(e.y & 0xffff0000u);
      }
      v[j].x = a.x + gg.x * yy.x; v[j].y = a.y + gg.y * yy.y; v[j].z = a.z + gg.z * yy.z; v[j].w = a.w + gg.w * yy.w;
      s += v[j].x * v[j].x + v[j].y * v[j].y + v[j].z * v[j].z + v[j].w * v[j].w;
    }
    s = wave_sum(s);
    const float rs = rsqrtf(s * (1.f / D) + 1e-6f);
#pragma unroll
    for (int j = 0; j < 4; ++j) {
      const float4 gg = ((const float4*)p.final_g)[lane + 64 * j];
      float4 o; o.x = v[j].x * rs * gg.x; o.y = v[j].y * rs * gg.y; o.z = v[j].z * rs * gg.z; o.w = v[j].w * rs * gg.w;
      ((float4*)(p.out + (size_t)t * D))[lane + 64 * j] = o;
    }
  }
  }
}

extern "C" void kernel_launch(void* const* d_in, const int* in_sizes, int n_in, void* d_out, int out_size, void* d_ws, size_t ws_size, hipStream_t stream) {
  static int grid_blocks = 0;
  if (!grid_blocks) {
    int dev = 0, cus = 0, per_cu = 0;
    (void)hipGetDevice(&dev);
    (void)hipDeviceGetAttribute(&cus, hipDeviceAttributeMultiprocessorCount, dev);
    (void)hipOccupancyMaxActiveBlocksPerMultiprocessor(&per_cu, fwd_megakernel, NT, 0);
    if (per_cu > 2) per_cu = 2;
    if (per_cu < 1) per_cu = 1;
    grid_blocks = cus * per_cu;
    if (n_in != 27 || ws_size < O_END) { fprintf(stderr, "kernel_launch: bad n_in %d or ws %zu < %zu\n", n_in, ws_size, (size_t)O_END); grid_blocks = -1; }
  }
  if (grid_blocks < 0) return;
  Params p{};
  const float** pp = (const float**)&p;
  for (int i = 0; i < 27; ++i) pp[i] = (const float*)d_in[i];
  p.out = (float*)d_out; p.ws = (unsigned char*)d_ws;
  (void)hipMemsetAsync((char*)d_ws + O_BAR, 0, XCD_BAR_WORDS_C * 4, stream);
  void* args[] = {&p};
  hipError_t e = hipLaunchCooperativeKernel((void*)fwd_megakernel, dim3(grid_blocks), dim3(NT), args, 0, stream);
  if (e != hipSuccess) fprintf(stderr, "cooperative launch failed: %s (grid %d)\n", hipGetErrorString(e), grid_blocks);
}
```
